# Optimizing an MI355X kernel written in HIP

```python
import math
import jax, jax.numpy as jnp
from jax import lax
import numpy as np

D_MODEL = 2048
BATCH = 4
SEQ = 2048
DEPTH = 2
DEC_BATCH = 128
DEC_SEQ = 4
PAST_LEN = 16384
PAGE_SIZE = 128

GLA_H = 4
GLA_DK = D_MODEL // 16
GLA_DV = D_MODEL // 8
GLA_RANK = 16
GATE_TAU = 16.0
GLA_CHUNK = 64
RET_H = 8
RET_DK = D_MODEL // 32
RET_DV = D_MODEL // 16
RET_CHUNK = 64
ROPE_BASE = 10000.0
CONV_DIM = D_MODEL // 2
CONV_W = 3
D_FF = 4 * D_MODEL
EPS = 1e-6
GN_EPS = 1e-5

IN_SIZES = (
    GLA_H * GLA_DK, GLA_H * GLA_DK, GLA_H * GLA_DV, GLA_RANK, GLA_H * GLA_DV,
    RET_H * RET_DK, RET_H * RET_DK, RET_H * RET_DV, RET_H * RET_DV,
    CONV_DIM, CONV_DIM, CONV_DIM,
    3 * D_MODEL,
)
IN_COLS = sum(IN_SIZES)

kernel_name = "hybrid_gla_retnet_shortconv_decode_step"


def rmsnorm(x, g):
    xf = x.astype(jnp.float32)
    y = xf * lax.rsqrt(jnp.mean(xf * xf, axis=-1, keepdims=True) + EPS)
    return (y * g.astype(jnp.float32)).astype(x.dtype)


def head_rmsnorm(o, g):
    B, T, H, DV = o.shape
    y = o * lax.rsqrt(jnp.mean(o * o, axis=-1, keepdims=True) + EPS)
    y = y * g.astype(jnp.float32).reshape(H, DV)
    return y.reshape(B, T, H * DV)


def head_groupnorm(o, w, b):
    B, T, H, DV = o.shape
    mu = jnp.mean(o, axis=-1, keepdims=True)
    c = o - mu
    y = c * lax.rsqrt(jnp.mean(c * c, axis=-1, keepdims=True) + GN_EPS)
    y = y * w.astype(jnp.float32).reshape(H, DV) + b.astype(jnp.float32).reshape(H, DV)
    return y.reshape(B, T, H * DV)


def rotary(x, pos):
    half = x.shape[-1] // 2
    inv_freq = ROPE_BASE ** (-jnp.arange(half, dtype=jnp.float32) / half)
    ang = pos[:, None] * inv_freq[None, :]
    cos = jnp.cos(ang)[None, :, None, :]
    sin = jnp.sin(ang)[None, :, None, :]
    x1, x2 = x[..., :half], x[..., half:]
    return jnp.concatenate([x1 * cos - x2 * sin, x1 * sin + x2 * cos], axis=-1)


def to_chunks(a, L):
    B, T = a.shape[0], a.shape[1]
    return a.reshape((B, T // L, L) + a.shape[2:]).swapaxes(0, 1)


def from_chunks(a):
    a = a.swapaxes(0, 1)
    return a.reshape((a.shape[0], a.shape[1] * a.shape[2]) + a.shape[3:])


def gla_chunked(q, k, v, log_a, S0):
    T = q.shape[1]
    L = math.gcd(T, GLA_CHUNK)
    causal = jnp.arange(L)[:, None] >= jnp.arange(L)[None, :]
    cmask = causal[None, :, :, None, None]

    def step(S, inp):
        qc, kc, vc, gc = inp
        b = jnp.cumsum(gc, axis=1)
        o_inter = jnp.einsum('blhk,bhkv->blhv', qc * jnp.exp(b), S)
        diff = b[:, :, None] - b[:, None, :]
        decay = jnp.where(cmask, jnp.exp(jnp.where(cmask, diff, 0.0)), 0.0)
        A = jnp.einsum('bthk,bshk,btshk->bths', qc, kc, decay)
        o_intra = jnp.einsum('bths,bshv->bthv', A, vc)
        bL = b[:, -1]
        k_dec = kc * jnp.exp(bL[:, None] - b)
        S_new = jnp.exp(bL)[..., None] * S + jnp.einsum('bshk,bshv->bhkv', k_dec, vc)
        return S_new, o_inter + o_intra

    S_fin, o = lax.scan(step, S0, (to_chunks(q, L), to_chunks(k, L), to_chunks(v, L), to_chunks(log_a, L)))
    return from_chunks(o), S_fin


def retention_chunked(q, k, v, log_gamma, R0):
    T = q.shape[1]
    L = math.gcd(T, RET_CHUNK)
    idx = jnp.arange(L, dtype=jnp.float32)
    diff = idx[:, None] - idx[None, :]
    causal = diff >= 0
    Dm = jnp.where(causal[None], jnp.exp(jnp.where(causal, diff, 0.0)[None] * log_gamma[:, None, None]), 0.0)
    xi = jnp.exp((idx[:, None] + 1.0) * log_gamma[None, :])
    zeta = jnp.exp((L - 1.0 - idx[:, None]) * log_gamma[None, :])
    gL = jnp.exp(L * log_gamma)

    def step(R, inp):
        qc, kc, vc = inp
        o_inter = jnp.einsum('blhk,bhkv->blhv', qc, R) * xi[None, :, :, None]
        A = jnp.einsum('bthk,bshk->bhts', qc, kc) * Dm[None]
        o_intra = jnp.einsum('bhts,bshv->bthv', A, vc)
        R_new = gL[None, :, None, None] * R + jnp.einsum('bshk,bshv->bhkv', kc * zeta[None, :, :, None], vc)
        return R_new, o_inter + o_intra

    R_fin, o = lax.scan(step, R0, (to_chunks(q, L), to_chunks(k, L), to_chunks(v, L)))
    return from_chunks(o), R_fin


def mixer_block(h, s_gla, s_ret, s_conv, pos, w_in, w_gate2, b_gate2, gla_g, ret_w, ret_b, conv_w,
                w_br_gla, w_br_ret, w_br_conv, w_o):
    Bt, T, _ = h.shape
    f32 = jnp.float32
    splits = np.cumsum(np.array(IN_SIZES))[:-1].tolist()
    z = h @ w_in
    qa, ka, va, alr, ra, qr, kr, vr, gr, cb, cc, ch, gates = jnp.split(z, splits, axis=-1)

    qa = qa.astype(f32).reshape(Bt, T, GLA_H, GLA_DK) * (GLA_DK ** -0.5)
    ka = ka.astype(f32).reshape(Bt, T, GLA_H, GLA_DK)
    va = va.astype(f32).reshape(Bt, T, GLA_H, GLA_DV)
    log_a = jax.nn.log_sigmoid((alr @ w_gate2 + b_gate2).astype(f32)) / GATE_TAU
    log_a = log_a.reshape(Bt, T, GLA_H, GLA_DK)
    oa, s_gla_new = gla_chunked(qa, ka, va, log_a, s_gla.astype(f32))
    oa = (head_rmsnorm(oa, gla_g) * jax.nn.silu(ra.astype(f32))).astype(h.dtype)

    log_gamma = jnp.log1p(-jnp.exp2(-5.0 - jnp.arange(RET_H, dtype=f32)))
    qr = rotary(qr.astype(f32).reshape(Bt, T, RET_H, RET_DK), pos) * (RET_DK ** -0.5)
    kr = rotary(kr.astype(f32).reshape(Bt, T, RET_H, RET_DK), pos)
    vr = vr.astype(f32).reshape(Bt, T, RET_H, RET_DV)
    ob, s_ret_new = retention_chunked(qr, kr, vr, log_gamma, s_ret.astype(f32))
    ob = (head_groupnorm(ob, ret_w, ret_b) * jax.nn.silu(gr.astype(f32))).astype(h.dtype)

    u = cc * ch
    ext = jnp.concatenate([s_conv.astype(u.dtype), u], axis=1)
    conv = sum(conv_w[j] * ext[:, j:j + T] for j in range(CONV_W))
    oc = cb * conv
    s_conv_new = ext[:, T:]

    g = jax.nn.sigmoid(gates.astype(f32)).astype(h.dtype)
    ga, gb, gc = jnp.split(g, 3, axis=-1)
    m = ga * (oa @ w_br_gla) + gb * (ob @ w_br_ret) + gc * (oc @ w_br_conv)
    out = m @ w_o
    return out, s_gla_new.astype(s_gla.dtype), s_ret_new.astype(s_ret.dtype), s_conv_new.astype(s_conv.dtype)


def trunk(x, st_gla, st_ret, st_conv, pos, params):
    (norm_mix, w_in, w_gate2, b_gate2, gla_norm, ret_norm_w, ret_norm_b, conv_w,
     w_branch_gla, w_branch_ret, w_branch_conv, w_out, norm_mlp, w_up, w_down, norm_final) = params
    new_gla, new_ret, new_conv = [], [], []
    for l in range(DEPTH):
        h = rmsnorm(x, norm_mix[l])
        mix, sg, sr, sc = mixer_block(h, st_gla[l], st_ret[l], st_conv[l], pos, w_in[l], w_gate2[l], b_gate2[l],
                                      gla_norm[l], ret_norm_w[l], ret_norm_b[l], conv_w[l],
                                      w_branch_gla[l], w_branch_ret[l], w_branch_conv[l], w_out[l])
        x = x + mix
        h = rmsnorm(x, norm_mlp[l])
        x = x + jnp.square(jax.nn.relu(h @ w_up[l])) @ w_down[l]
        new_gla.append(sg)
        new_ret.append(sr)
        new_conv.append(sc)
    y = rmsnorm(x, norm_final)
    return y, jnp.stack(new_gla), jnp.stack(new_ret), jnp.stack(new_conv)


def setup_inputs(seed: int = 0) -> dict:
    key = jax.random.key(seed)
    ks = jax.random.split(key, 24)
    nrm = lambda k, shape, s: jax.random.normal(k, shape, jnp.float32) * s
    D = D_MODEL
    return {
        "x_prompt": nrm(ks[0], (BATCH, SEQ, D), 1.0),
        "x_sample": nrm(ks[1], (DEC_BATCH, DEC_SEQ, D), 1.0),
        "state_gla": nrm(ks[2], (DEPTH, DEC_BATCH, GLA_H, GLA_DK, GLA_DV), 0.5),
        "state_ret": nrm(ks[3], (DEPTH, DEC_BATCH, RET_H, RET_DK, RET_DV), 0.5),
        "state_conv": nrm(ks[4], (DEPTH, DEC_BATCH, CONV_W - 1, CONV_DIM), 0.5),
        "norm_mix": 1.0 + nrm(ks[5], (DEPTH, D), 0.02),
        "w_in": nrm(ks[6], (DEPTH, D, IN_COLS), D ** -0.5),
        "w_gate2": nrm(ks[7], (DEPTH, GLA_RANK, GLA_H * GLA_DK), GLA_RANK ** -0.5),
        "b_gate2": nrm(ks[8], (DEPTH, GLA_H * GLA_DK), 0.1),
        "gla_norm": 1.0 + nrm(ks[9], (DEPTH, GLA_H * GLA_DV), 0.02),
        "ret_norm_w": 1.0 + nrm(ks[10], (DEPTH, RET_H * RET_DV), 0.02),
        "ret_norm_b": nrm(ks[11], (DEPTH, RET_H * RET_DV), 0.02),
        "conv_w": nrm(ks[12], (DEPTH, CONV_W, CONV_DIM), CONV_W ** -0.5),
        "w_branch_gla": nrm(ks[13], (DEPTH, GLA_H * GLA_DV, D), (GLA_H * GLA_DV) ** -0.5),
        "w_branch_ret": nrm(ks[14], (DEPTH, RET_H * RET_DV, D), (RET_H * RET_DV) ** -0.5),
        "w_branch_conv": nrm(ks[15], (DEPTH, CONV_DIM, D), CONV_DIM ** -0.5),
        "w_out": nrm(ks[16], (DEPTH, D, D), D ** -0.5),
        "norm_mlp": 1.0 + nrm(ks[17], (DEPTH, D), 0.02),
        "w_up": nrm(ks[18], (DEPTH, D, D_FF), D ** -0.5),
        "w_down": nrm(ks[19], (DEPTH, D_FF, D), D_FF ** -0.5),
        "norm_final": 1.0 + nrm(ks[20], (D,), 0.02),
    }


def reference(x_prompt, x_sample, state_gla, state_ret, state_conv, norm_mix, w_in, w_gate2, b_gate2,
              gla_norm, ret_norm_w, ret_norm_b, conv_w, w_branch_gla, w_branch_ret, w_branch_conv, w_out,
              norm_mlp, w_up, w_down, norm_final):
    params = (norm_mix, w_in, w_gate2, b_gate2, gla_norm, ret_norm_w, ret_norm_b, conv_w,
              w_branch_gla, w_branch_ret, w_branch_conv, w_out, norm_mlp, w_up, w_down, norm_final)
    Bp, Tp = x_prompt.shape[0], x_prompt.shape[1]
    Ts = x_sample.shape[1]
    z_gla = jnp.zeros((DEPTH, Bp) + state_gla.shape[2:], state_gla.dtype)
    z_ret = jnp.zeros((DEPTH, Bp) + state_ret.shape[2:], state_ret.dtype)
    z_conv = jnp.zeros((DEPTH, Bp) + state_conv.shape[2:], state_conv.dtype)
    pos_p = jnp.arange(Tp, dtype=jnp.float32)
    y_prompt, gla_p, ret_p, conv_p = trunk(x_prompt, z_gla, z_ret, z_conv, pos_p, params)
    pos_s = PAST_LEN + jnp.arange(Ts, dtype=jnp.float32)
    y_sample, gla_s, ret_s, conv_s = trunk(x_sample, state_gla, state_ret, state_conv, pos_s, params)
    return (y_prompt, y_sample, gla_p, ret_p, conv_p, gla_s, ret_s, conv_s)
```

```cpp
#include <hip/hip_runtime.h>
#include <hip/hip_cooperative_groups.h>
#include <cstdio>
namespace cg = cooperative_groups;

#ifndef MK_MULTI
#define MK_MULTI 0
#endif

#ifndef PHMASK
#define PHMASK 0xffff
#endif
#define PHON(b) ((PHMASK >> (b)) & 1)
#define LAS __attribute__((address_space(3)))
#define DI __device__ __forceinline__
typedef unsigned short bf16_t;
typedef short bf16x8 __attribute__((ext_vector_type(8)));
typedef short s16x4 __attribute__((ext_vector_type(4)));
typedef float f32x2 __attribute__((ext_vector_type(2)));
typedef float f32x4 __attribute__((ext_vector_type(4)));
typedef float f32x16 __attribute__((ext_vector_type(16)));
typedef unsigned u32x4 __attribute__((ext_vector_type(4)));
typedef unsigned u32x2 __attribute__((ext_vector_type(2)));
typedef __bf16 bf16x2_t __attribute__((ext_vector_type(2)));

constexpr int D = 2048, MP = 8192, MS = 512, MROWS = 8704, TP = 2048;
constexpr int INC = 15376;
constexpr int NZ = 15360;
constexpr int ZQA = 0, ZKA = 512, ZVA = 1024, ZRA = 2048, ZQR = 3072, ZKR = 3584, ZVR = 4096, ZGR = 5120, ZCB = 6144, ZCC = 7168, ZCH = 8192, ZGATE = 9216;
constexpr int DFF = 8192;
constexpr int LDS_XB = 149504;
constexpr int LDS_BYTES = LDS_XB + 16;
constexpr size_t O_YP = 0, O_YS = 16777216, O_GLAP = 17825792, O_RETP = 18874368, O_CONVP = 19398656, O_GLAS = 19415040, O_RETS = 52969472, O_CONVS = 69746688;
constexpr size_t SZ_WIN = (size_t)NZ * D * 2, SZ_WBR = (size_t)D * 3072 * 2, SZ_WO = (size_t)D * D * 2, SZ_WUP = (size_t)DFF * D * 2, SZ_WDN = (size_t)D * DFF * 2;
constexpr size_t WS_WIN = 0, WS_WBR = WS_WIN + 2 * SZ_WIN, WS_WO = WS_WBR + 2 * SZ_WBR, WS_WUP = WS_WO + 2 * SZ_WO, WS_WDN = WS_WUP + 2 * SZ_WUP;
constexpr size_t WS_X = WS_WDN + 2 * SZ_WDN;
constexpr size_t WS_H = WS_X + (size_t)MROWS * D * 4;
constexpr size_t WS_Z = WS_H + (size_t)MROWS * D * 2;
constexpr size_t WS_ALR = WS_Z + (size_t)MROWS * NZ * 2;
constexpr size_t WS_OCAT = WS_ALR + (size_t)MROWS * 16 * 4;
constexpr size_t WS_M = WS_OCAT + (size_t)MROWS * 3072 * 2;
constexpr size_t WS_MT = WS_M + (size_t)MROWS * D * 2;
constexpr size_t WS_IMG = WS_MT + (size_t)MROWS * D * 4;
constexpr size_t WS_BAR = WS_IMG + (size_t)1024 * 93184;
constexpr size_t WS_END = WS_BAR + 16384;

__device__ const double INVF_REV[32] = {0.15915494309189535, 0.11934937021124886, 0.08949940160889101, 0.06711508300522726, 0.050329212104487035, 0.03774158471741977, 0.0283021958306234, 0.02122365276477766, 0.015915494309189534, 0.011934937021124886, 0.008949940160889102, 0.006711508300522725, 0.005032921210448704, 0.003774158471741977, 0.00283021958306234, 0.0021223652764777662, 0.0015915494309189536, 0.0011934937021124885, 0.0008949940160889102, 0.0006711508300522726, 0.0005032921210448703, 0.00037741584717419774, 0.00028302195830623395, 0.0002122365276477766, 0.00015915494309189535, 0.00011934937021124886, 8.949940160889102e-05, 6.711508300522725e-05, 5.0329212104487035e-05, 3.774158471741978e-05, 2.8302195830623396e-05, 2.122365276477766e-05};
struct Args { const float* in[21]; float* out; unsigned char* ws; int ph_lo, ph_hi; };

DI unsigned pk2(float a, float b) { f32x2 v = {a, b}; bf16x2_t r = __builtin_convertvector(v, bf16x2_t); return __builtin_bit_cast(unsigned, r); }
DI bf16_t f2bf(float a) { return (bf16_t)(pk2(a, 0.f) & 0xffffu); }
DI float bf2f(bf16_t b) { return __uint_as_float(((unsigned)b) << 16); }
DI float bflo(unsigned w) { return __uint_as_float(w << 16); }
DI float bfhi(unsigned w) { return __uint_as_float(w & 0xffff0000u); }
DI float sigmoidf_(float x) { return __builtin_amdgcn_rcpf(1.0f + __expf(-x)); }
DI float siluf_(float x) { return x * sigmoidf_(x); }
DI float logsigmoidf_(float x) { return fminf(x, 0.f) - log1pf(__expf(-fabsf(x))); }
DI int crow(int reg, int h) { return (reg & 3) + 8 * (reg >> 2) + 4 * h; }
DI bf16x8 pack_step(const f32x16& x, int s) {
    u32x4 p;
    p[0] = pk2(x[8 * s + 0], x[8 * s + 1]); p[1] = pk2(x[8 * s + 2], x[8 * s + 3]);
    p[2] = pk2(x[8 * s + 4], x[8 * s + 5]); p[3] = pk2(x[8 * s + 6], x[8 * s + 7]);
    return __builtin_bit_cast(bf16x8, p);
}
DI bf16x8 cat4(s16x4 lo, s16x4 hi) { return __builtin_shufflevector(lo, hi, 0, 1, 2, 3, 4, 5, 6, 7); }
#define MFMA32(a, b, c) __builtin_amdgcn_mfma_f32_32x32x16_bf16((a), (b), (c), 0, 0, 0)

namespace pg8 {
constexpr int BM = 256, BK = 64, HALF = 128, HTB = HALF * BK * 2, NXCD = 8, WGM = 8;
DI int lds_byte(int r, int c) { const int st = (r >> 4) * 2 + (c >> 5), rr = r & 15, cc = c & 31, ob = rr * 64 + cc * 2; return st * 1024 + (ob ^ (((ob >> 9) & 1) << 5)); }
DI void stage_rc(int b, int& R, int& C) { const int st = b / 1024, sb = b % 1024, swz = sb ^ (((sb >> 9) & 1) << 5); R = (st >> 1) * 16 + swz / 64; C = (st & 1) * 32 + (swz % 64) / 2; }
DI int perm32(int rho) { const int n = rho >> 4, i = rho & 15; return 8 * (i >> 2) + 4 * n + (i & 3); }

struct Unit { int pm, pn, kt0, nt; };
struct Gemm { const bf16_t* A; const bf16_t* Bt; int ld; };

DI void map_tile(int wgid, int nM, int nN, int& pm, int& pn) {
    const int nwg = nM * nN;
    { const int q = nwg / NXCD, r = nwg % NXCD, xcd = wgid % NXCD, off = wgid / NXCD; wgid = (xcd < r ? xcd * (q + 1) : r * (q + 1) + (xcd - r) * q) + off; }
    const int nig = WGM * nN, gid = wgid / nig, fm = gid * WGM, gsz = (nM - fm) < WGM ? (nM - fm) : WGM;
    pm = fm + ((wgid % nig) % gsz); pn = (wgid % nig) / gsz;
}
struct StaticOrder {
    int nM, nN, nwg, G, c, nt;
    DI void init(int M, int N, int K, int G_, int c_) { nM = M / BM; nN = N / BM; nwg = nM * nN; G = G_; c = c_; nt = K / BK; }
    DI bool next(int i, Unit& u) const {
        const long L = (long)i * G + c; if (L >= nwg) return false;
        map_tile((int)L, nM, nN, u.pm, u.pn); u.kt0 = 0; u.nt = nt; return true;
    }
};
struct SegOrder {
    int nM, nN, nwg, G, c;
    DI void init(int M, int N, int G_, int c_) { nM = M / BM; nN = N / BM; nwg = nM * nN; G = G_; c = c_; }
    DI bool next(int i, Unit& u) const {
        const long L = (long)i * G + c; if (L >= 3 * nwg) return false;
        const int br = (int)(L / nwg), t = (int)(L - (long)br * nwg);
        map_tile(t, nM, nN, u.pm, u.pn); u.kt0 = br * 16; u.nt = 16; return true;
    }
};
struct TailOrder {
    int c, nt, ls;
    DI void init(int K, int c_, int ls_) { c = c_; nt = K / BK; ls = ls_; }
    DI bool next(int i, Unit& u) const {
        if (i == 0) { map_tile(c, 32, 8, u.pm, u.pn); u.kt0 = 0; u.nt = nt; return true; }
        if (i == 1 && c < (16 << ls)) { const int ts = c >> ls, piece = c & ((1 << ls) - 1); u.pm = 32 + (ts >> 3); u.pn = ts & 7; u.nt = nt >> ls; u.kt0 = piece * u.nt; return true; }
        return false;
    }
};

template <int ACT> struct EpiBf16 {
    static constexpr bool PERM = true;
    bf16_t* O; int ldc; int segN;
    DI void operator()(const f32x4 (&acc)[2][2][4][2], const Unit& u, int wr, int wc, int fr, int fq) const {
        const int row0 = u.pm * BM + wr * 64 + fr, col0 = u.pn * BM + (u.kt0 >> 4) * segN + wc * 32 + 8 * fq;
#pragma unroll
        for (int ai = 0; ai < 2; ++ai)
#pragma unroll
            for (int m = 0; m < 4; ++m) { bf16_t* rowp = O + (size_t)(row0 + ai * HALF + m * 16) * ldc + col0;
#pragma unroll
                for (int bj = 0; bj < 2; ++bj) { f32x4 v0 = acc[ai][bj][m][0], v1 = acc[ai][bj][m][1];
                    if (ACT == 1) {
#pragma unroll
                        for (int j = 0; j < 4; ++j) { const float a = fmaxf(v0[j], 0.f), b = fmaxf(v1[j], 0.f); v0[j] = a * a; v1[j] = b * b; } }
                    u32x4 w; w.x = pk2(v0[0], v0[1]); w.y = pk2(v0[2], v0[3]); w.z = pk2(v1[0], v1[1]); w.w = pk2(v1[2], v1[3]);
                    *(u32x4*)(rowp + bj * HALF) = w; } }
    }
};
struct EpiRes {
    static constexpr bool PERM = false;
    const float* bp; float* out; float* part;
    DI void operator()(const f32x4 (&acc)[2][2][4][2], const Unit& u, int wr, int wc, int fr, int fq) const {
        const bool tail = u.pm >= 32;
        const size_t off0 = (size_t)((tail ? (u.kt0 / u.nt) * MS - MP : 0) + u.pm * BM + wr * 64 + fr) * D + u.pn * BM + wc * 32 + 4 * fq;
#pragma unroll
        for (int ai = 0; ai < 2; ++ai)
#pragma unroll
            for (int m = 0; m < 4; ++m) { const size_t off = off0 + (size_t)(ai * HALF + m * 16) * D;
                float* o = out + off + (tail ? (size_t)((WS_IMG - WS_X) / 4) : (size_t)0);
                if (tail) {
#pragma unroll
                    for (int bj = 0; bj < 2; ++bj)
#pragma unroll
                        for (int n = 0; n < 2; ++n) { float* p = o + bj * HALF + n * 16;
                            *(f32x4*)p = acc[ai][bj][m][n]; }
                } else {
                    const float* b = bp + off;
#pragma unroll
                    for (int bj = 0; bj < 2; ++bj)
#pragma unroll
                        for (int n = 0; n < 2; ++n) { const int c = bj * HALF + n * 16; *(f32x4*)(o + c) = *(const f32x4*)(b + c) + acc[ai][bj][m][n]; }
                }
                asm volatile("" ::: "memory"); }
    }
};
template <class Epi, class Sched>
DI void gemm_phase(LAS unsigned char* lds, const int tid, const Gemm g, const Sched& S, const Epi& E) {
    const int wid = __builtin_amdgcn_readfirstlane(tid >> 6), lane = tid & 63, wr = wid >> 2, wc = wid & 3, fr = lane & 15, fq = lane >> 4;
    const int K = g.ld;
    unsigned voffA[2], voffB[2];
#pragma unroll
    for (int i = 0; i < 2; ++i) { int R, C; stage_rc(tid * 16 + i * 8192, R, C); const int Rb = Epi::PERM ? ((R & ~31) + perm32(R & 31)) : R;
        voffA[i] = (unsigned)(R * K + C) * 2u; voffB[i] = (unsigned)(Rb * K + C) * 2u; }
    const size_t kstep = (size_t)(BK * 2);
    const size_t hstep = (size_t)HALF * K * 2;
    const size_t tstep = 2 * hstep;
    const unsigned ldsw = (unsigned)wid * 1024u;
    const int aoff = lds_byte(wr * 64 + fr, fq * 8), boff = lds_byte(wc * 32 + fr, fq * 8);
#define PG8_SA(b, h) (((b) * 2 + (h)) * HTB)
#define PG8_SB(b, h) ((4 + (b) * 2 + (h)) * HTB)
#define PG8_STAGE(bufoff, gbase, voff) do { _Pragma("unroll") for (int _i = 0; _i < 2; ++_i) \
        __builtin_amdgcn_global_load_lds((const unsigned*)((const char*)(gbase) + (voff)[_i]), (LAS unsigned*)(lds + (bufoff) + ldsw + _i * 8192), 16, 0, 0); } while (0)
#define PG8_LDA(dst, b, h) do { _Pragma("unroll") for (int m = 0; m < 4; ++m) _Pragma("unroll") for (int k = 0; k < 2; ++k) dst[m][k] = *(const LAS bf16x8*)(lds + PG8_SA(b, h) + aoff + m * 2048 + k * 1024); } while (0)
#define PG8_LDB(dst, b, h) do { _Pragma("unroll") for (int n = 0; n < 2; ++n) _Pragma("unroll") for (int k = 0; k < 2; ++k) dst[n][k] = *(const LAS bf16x8*)(lds + PG8_SB(b, h) + boff + n * 2048 + k * 1024); } while (0)
#define PG8_MMA(ai, bj, At, Bt) do { __builtin_amdgcn_s_setprio(1); _Pragma("unroll") for (int m = 0; m < 4; ++m) _Pragma("unroll") for (int n = 0; n < 2; ++n) _Pragma("unroll") for (int k = 0; k < 2; ++k) \
        acc[ai][bj][m][n] = __builtin_amdgcn_mfma_f32_16x16x32_bf16(Bt[n][k], At[m][k], acc[ai][bj][m][n], 0, 0, 0); __builtin_amdgcn_s_setprio(0); } while (0)
#define PG8_WAIT_V(n) asm volatile("s_waitcnt vmcnt(" #n ")" ::: "memory")
#define PG8_WAIT_L(n) asm volatile("s_waitcnt lgkmcnt(" #n ")" ::: "memory")
#define PG8_BAR __builtin_amdgcn_s_barrier()
#define PG8_SCHED __builtin_amdgcn_sched_barrier(0)
    Unit cur, nxt; int ui = 0;
    if (!S.next(0, cur)) return;
    f32x4 acc[2][2][4][2];
#pragma unroll
    for (int a = 0; a < 2; ++a)
#pragma unroll
        for (int b = 0; b < 2; ++b)
#pragma unroll
            for (int m = 0; m < 4; ++m)
#pragma unroll
                for (int n = 0; n < 2; ++n) acc[a][b][m][n] = (f32x4){0.f, 0.f, 0.f, 0.f};
    bf16x8 At[4][2], B0[2][2], B1[2][2];
    const char* cA = (const char*)g.A + (size_t)cur.pm * tstep + (size_t)cur.kt0 * kstep;
    const char* cB = (const char*)g.Bt + (size_t)cur.pn * tstep + (size_t)cur.kt0 * kstep;
    PG8_STAGE(PG8_SB(0, 0), cB, voffB); PG8_STAGE(PG8_SB(0, 1), cB + hstep, voffB); PG8_STAGE(PG8_SA(0, 0), cA, voffA); PG8_STAGE(PG8_SA(0, 1), cA + hstep, voffA);
    if (wr == 1) PG8_BAR;
    PG8_WAIT_V(2); PG8_BAR;
    PG8_STAGE(PG8_SB(1, 0), cB + kstep, voffB); PG8_STAGE(PG8_SA(1, 0), cA + kstep, voffA); PG8_STAGE(PG8_SB(1, 1), cB + hstep + kstep, voffB);
    PG8_WAIT_V(6); PG8_BAR;
    for (;;) {
        const bool has_next = S.next(ui + 1, nxt);
        const char* nA = has_next ? (const char*)g.A + (size_t)nxt.pm * tstep + (size_t)nxt.kt0 * kstep : cA;
        const char* nB = has_next ? (const char*)g.Bt + (size_t)nxt.pn * tstep + (size_t)nxt.kt0 * kstep : cB;
        const int nt = cur.nt;
        for (int t = 0; t < nt; t += 2) {
            const bool last = (t == nt - 2);
            const char* a1 = cA + (size_t)(t + 1) * kstep;
            const char* a2 = last ? nA : cA + (size_t)(t + 2) * kstep; const char* b2 = last ? nB : cB + (size_t)(t + 2) * kstep;
            const char* a3 = a2 + kstep; const char* b3 = b2 + kstep;
            PG8_LDB(B0, 0, 0); PG8_LDB(B1, 0, 1); PG8_SCHED; PG8_LDA(At, 0, 0); PG8_STAGE(PG8_SA(1, 1), a1 + hstep, voffA);
            PG8_WAIT_V(8); PG8_WAIT_L(0); PG8_BAR; PG8_MMA(0, 0, At, B0); PG8_MMA(0, 1, At, B1); PG8_BAR; PG8_SCHED;
            PG8_LDA(At, 0, 1); PG8_STAGE(PG8_SB(0, 0), b2, voffB); PG8_STAGE(PG8_SB(0, 1), b2 + hstep, voffB); PG8_STAGE(PG8_SA(0, 0), a2, voffA);
            PG8_WAIT_V(8); PG8_WAIT_L(0); PG8_BAR; PG8_MMA(1, 0, At, B0); PG8_MMA(1, 1, At, B1); PG8_BAR; PG8_SCHED;
            PG8_LDB(B0, 1, 0); PG8_LDB(B1, 1, 1); PG8_SCHED; PG8_LDA(At, 1, 0); PG8_STAGE(PG8_SA(0, 1), a2 + hstep, voffA);
            PG8_WAIT_V(8); PG8_WAIT_L(0); PG8_BAR; PG8_MMA(0, 0, At, B0); PG8_MMA(0, 1, At, B1); PG8_BAR; PG8_SCHED;
            PG8_LDA(At, 1, 1); PG8_STAGE(PG8_SB(1, 0), b3, voffB); PG8_STAGE(PG8_SB(1, 1), b3 + hstep, voffB); PG8_STAGE(PG8_SA(1, 0), a3, voffA);
            PG8_WAIT_V(8); PG8_WAIT_L(0); PG8_BAR; PG8_MMA(1, 0, At, B0); PG8_MMA(1, 1, At, B1); PG8_BAR; PG8_SCHED;
        }
        if (wr == 0) PG8_BAR;
        E(acc, cur, wr, wc, fr, fq);
        if (!has_next) break;
#pragma unroll
        for (int a = 0; a < 2; ++a)
#pragma unroll
            for (int b = 0; b < 2; ++b)
#pragma unroll
                for (int m = 0; m < 4; ++m)
#pragma unroll
                    for (int n = 0; n < 2; ++n) acc[a][b][m][n] = (f32x4){0.f, 0.f, 0.f, 0.f};
        cur = nxt; cA = nA; cB = nB; ++ui;
        if (wr == 1) PG8_BAR;
    }
    PG8_WAIT_V(0);
    PG8_BAR;
#undef PG8_SA
#undef PG8_SB
#undef PG8_STAGE
#undef PG8_LDA
#undef PG8_LDB
#undef PG8_MMA
#undef PG8_WAIT_V
#undef PG8_WAIT_L
#undef PG8_BAR
#undef PG8_SCHED
}
}

struct Ctx {
    const float *in0, *in1, *in2, *in3, *in4, *in5, *in6, *in7, *in8, *in9, *in10, *in11, *in12, *in13, *in14, *in15, *in16, *in17, *in18, *in19, *in20; float* out; unsigned char* ws; LAS unsigned char* lds; int tid, lane, wave, G, blk;
    DI bf16_t* wt_in(int l) const { return (bf16_t*)(ws + WS_WIN + (size_t)l * SZ_WIN); }
    DI bf16_t* wt_br(int l) const { return (bf16_t*)(ws + WS_WBR + (size_t)l * SZ_WBR); }
    DI bf16_t* wt_o(int l) const { return (bf16_t*)(ws + WS_WO + (size_t)l * SZ_WO); }
    DI bf16_t* wt_up(int l) const { return (bf16_t*)(ws + WS_WUP + (size_t)l * SZ_WUP); }
    DI bf16_t* wt_dn(int l) const { return (bf16_t*)(ws + WS_WDN + (size_t)l * SZ_WDN); }
    DI float* xws() const { return (float*)(ws + WS_X); }
    DI bf16_t* hb() const { return (bf16_t*)(ws + WS_H); }
    DI bf16_t* zb() const { return (bf16_t*)(ws + WS_Z); }
    DI float* alr() const { return (float*)(ws + WS_ALR); }
    DI bf16_t* ocat() const { return (bf16_t*)(ws + WS_OCAT); }
    DI bf16_t* mb() const { return (bf16_t*)(ws + WS_M); }
    DI bf16_t* pbr() const { return (bf16_t*)(ws + WS_MT); }
    DI float* part() const { return (float*)(ws + WS_IMG); }
};

DI void convert_tile(const Ctx& F, const float* src, int ldsrc, int n0src, bf16_t* dst, int ldd, int n0, int k0) {
    LAS bf16_t* T = (LAS bf16_t*)F.lds;
    constexpr int LT = 264;
    const int tid = F.tid;
    const int n4 = tid & 15, kr = tid >> 4;
    f32x4 v[8];
#pragma unroll
    for (int p = 0; p < 8; ++p) v[p] = *(const f32x4*)(src + (size_t)(k0 + kr + 32 * p) * ldsrc + n0src + n4 * 4);
#pragma unroll
    for (int p = 0; p < 8; ++p) { const int k = kr + 32 * p;
#pragma unroll
        for (int e = 0; e < 4; ++e) T[(n4 * 4 + e) * LT + k] = f2bf(v[p][e]); }
    __syncthreads();
    const int kc = tid & 31, nr = tid >> 5;
#pragma unroll
    for (int p = 0; p < 4; ++p) { const int n = nr + 16 * p;
        const u32x4 w = *(const LAS u32x4*)(T + n * LT + kc * 8);
        *(u32x4*)(dst + (size_t)(n0 + n) * ldd + k0 + kc * 8) = w; }
    __syncthreads();
}
DI void phase_convert(const Ctx& F, const int l, const int wg, const int nwg, const int jobs) {
    int base = 0;
#define CV_JOB(count, ...) do { for (int t = (((wg - base) % nwg) + nwg) % nwg; t < (count); t += nwg) { __VA_ARGS__; } base += (count); } while (0)
    if (jobs & 1) CV_JOB(960, { const int nt_ = t % 240, kt_ = t / 240; const int n0 = nt_ * 64; const int n0s = n0 + (n0 >= 2048 ? 16 : 0);
        convert_tile(F, F.in6 + (size_t)l * D * INC, INC, n0s, F.wt_in(l), D, n0, kt_ * 256); });
    if (jobs & 16) CV_JOB(960, { const int t2 = t + 960; const int nt_ = t2 % 240, kt_ = t2 / 240; const int n0 = nt_ * 64; const int n0s = n0 + (n0 >= 2048 ? 16 : 0);
        convert_tile(F, F.in6 + (size_t)l * D * INC, INC, n0s, F.wt_in(l), D, n0, kt_ * 256); });
    if (jobs & 2) { CV_JOB(128, { const int nt_ = t % 32, kt_ = t / 32; convert_tile(F, F.in13 + (size_t)l * 1024 * D, D, nt_ * 64, F.wt_br(l), 3072, nt_ * 64, kt_ * 256); });
    CV_JOB(128, { const int nt_ = t % 32, kt_ = t / 32; convert_tile(F, F.in14 + (size_t)l * 1024 * D, D, nt_ * 64, F.wt_br(l) + 1024, 3072, nt_ * 64, kt_ * 256); });
    CV_JOB(128, { const int nt_ = t % 32, kt_ = t / 32; convert_tile(F, F.in15 + (size_t)l * 1024 * D, D, nt_ * 64, F.wt_br(l) + 2048, 3072, nt_ * 64, kt_ * 256); });
    CV_JOB(256, { const int nt_ = t % 32, kt_ = t / 32; convert_tile(F, F.in16 + (size_t)l * D * D, D, nt_ * 64, F.wt_o(l), D, nt_ * 64, kt_ * 256); }); }
    if (jobs & 4) { CV_JOB(1024, { const int nt_ = t % 128, kt_ = t / 128; convert_tile(F, F.in18 + (size_t)l * D * DFF, DFF, nt_ * 64, F.wt_up(l), D, nt_ * 64, kt_ * 256); }); }
    if (jobs & 8) { CV_JOB(1024, { const int nt_ = t % 32, kt_ = t / 32; convert_tile(F, F.in19 + (size_t)l * DFF * D, D, nt_ * 64, F.wt_dn(l), DFF, nt_ * 64, kt_ * 256); }); }
#undef CV_JOB
}

DI float wave_sum(float v) {
#pragma unroll
    for (int o = 32; o >= 1; o >>= 1) v += __shfl_xor(v, o);
    return v;
}
template <int MODE>
DI void norm_row(const Ctx& F, int row, bool from_input, const f32x4 (&gv)[8], f32x4 (&xv)[8], int lane) {
    const float* xr = from_input ? ((row < MP) ? F.in0 + (size_t)row * D : F.in1 + (size_t)(row - MP) * D) : F.xws() + (size_t)row * D;
#pragma unroll
    for (int i = 0; i < 8; ++i) xv[i] = *(const f32x4*)(xr + i * 256 + lane * 4);
    if (!from_input && row >= MP) {
#pragma unroll 1
        for (int p = 0; p < (MODE == 1 ? 4 : 8); ++p) { const float* pr = F.part() + ((size_t)p * MS + (row - MP)) * D;
#pragma unroll
            for (int i = 0; i < 8; ++i) xv[i] += *(const f32x4*)(pr + i * 256 + lane * 4); }
        float* xo = F.xws() + (size_t)row * D;
#pragma unroll
        for (int i = 0; i < 8; ++i) *(f32x4*)(xo + i * 256 + lane * 4) = xv[i];
    }
    if (MODE == 0 && from_input && row >= MP) {
        float* xo = F.xws() + (size_t)row * D;
#pragma unroll
        for (int i = 0; i < 8; ++i) *(f32x4*)(xo + i * 256 + lane * 4) = xv[i];
    }
    float ss = 0.f;
#pragma unroll
    for (int i = 0; i < 8; ++i) ss += xv[i][0] * xv[i][0] + xv[i][1] * xv[i][1] + xv[i][2] * xv[i][2] + xv[i][3] * xv[i][3];
    ss = wave_sum(ss);
    const float rstd = rsqrtf(ss * (1.0f / 2048.0f) + 1e-6f);
#pragma unroll
    for (int i = 0; i < 8; ++i) xv[i] = xv[i] * rstd * gv[i];
    if (MODE == 2) {
        float* o = F.out + O_YP + (size_t)row * D;
#pragma unroll
        for (int i = 0; i < 8; ++i) *(f32x4*)(o + i * 256 + lane * 4) = xv[i];
    } else {
        bf16_t* o = F.hb() + (size_t)row * D;
#pragma unroll
        for (int i = 0; i < 8; ++i) { u32x2 w; w.x = pk2(xv[i][0], xv[i][1]); w.y = pk2(xv[i][2], xv[i][3]); *(u32x2*)(o + i * 256 + lane * 4) = w; }
    }
}
template <int MODE>
DI void phase_norm(const Ctx& F, int l, bool from_input) {
    const int tid = F.tid, lane = F.lane, wave = F.wave;
    LAS float* WL = (LAS float*)F.lds;
    if (MODE == 0) {
        const float* w = F.in6 + (size_t)l * D * INC + 2048;
        for (int idx = tid; idx < 2048 * 4; idx += 512) { const int k = idx >> 2, j4 = idx & 3;
            const f32x4 v = *(const f32x4*)(w + (size_t)k * INC + j4 * 4);
            WL[(j4 * 4 + 0) * 2048 + k] = v[0]; WL[(j4 * 4 + 1) * 2048 + k] = v[1]; WL[(j4 * 4 + 2) * 2048 + k] = v[2]; WL[(j4 * 4 + 3) * 2048 + k] = v[3]; }
        __syncthreads();
    }
    const float* gain = (MODE == 0) ? F.in5 + l * D : (MODE == 1) ? F.in17 + l * D : F.in20;
    f32x4 gv[8];
#pragma unroll
    for (int i = 0; i < 8; ++i) gv[i] = *(const f32x4*)(gain + i * 256 + lane * 4);
    const int wslot = F.blk * 8 + wave;
    if (MODE != 0) {
        for (int it = 0; it < 5; ++it) {
            int row = it * 2048 + wslot;
            if (it == 4) { if (wslot & 3) break; row = MP + (wslot >> 2); }
            f32x4 xv[8];
            norm_row<MODE>(F, row, from_input, gv, xv, lane);
        }
    } else {
        for (int pr = 0; pr < 3; ++pr) {
            int row0 = 2 * pr * 2048 + wslot, row1 = row0 + 2048; bool two = true;
            if (pr == 2) { if (wslot & 3) break; row0 = MP + (wslot >> 2); row1 = row0; two = false; }
            f32x4 xa[8], xb[8];
            norm_row<MODE>(F, row0, from_input, gv, xa, lane);
            if (two) norm_row<MODE>(F, row1, from_input, gv, xb, lane);
            else {
#pragma unroll
                for (int i = 0; i < 8; ++i) xb[i] = xa[i];
            }
            float r0 = 0.f, r1 = 0.f;
#pragma unroll 1
            for (int j = 0; j < 16; ++j) { float s0 = 0.f, s1 = 0.f;
#pragma unroll
                for (int i = 0; i < 8; ++i) { const f32x4 w = *(const LAS f32x4*)(WL + j * 2048 + i * 256 + lane * 4);
                    s0 += xa[i][0] * w[0] + xa[i][1] * w[1] + xa[i][2] * w[2] + xa[i][3] * w[3];
                    s1 += xb[i][0] * w[0] + xb[i][1] * w[1] + xb[i][2] * w[2] + xb[i][3] * w[3]; }
                s0 = wave_sum(s0); s1 = wave_sum(s1);
                r0 = (lane == j) ? s0 : r0; r1 = (lane == j) ? s1 : r1; }
            if (lane < 16) { F.alr()[(size_t)row0 * 16 + lane] = r0; if (two) F.alr()[(size_t)row1 * 16 + lane] = r1; }
        }
    }
    __syncthreads();
}

constexpr int MX_QT = 0, MX_KT = 18432, MX_KTT = 36864, MX_VT = 55296, MX_EBL = 92160, MX_LDT = 72;
constexpr int IMG_BYTES = 93184;
constexpr int MX_PS = 93184, MX_AL = 95232, MX_W2 = 99328;
constexpr int MX_OSB = 93184, MX_LDOB = 264;

template <bool GLA>
DI void mix_prep(const Ctx& F, int l, int item, int c) {
    constexpr int DK = GLA ? 128 : 64;
    constexpr int LDQ = DK + 8, LDT = MX_LDT;
    constexpr int QOFF = GLA ? ZQA : ZQR, KOFF = GLA ? ZKA : ZKR, VOFF = GLA ? ZVA : ZVR;
    int tid_ = F.tid; asm volatile("" : "+v"(tid_));
    const int tid = tid_;
    LAS bf16_t* QT = (LAS bf16_t*)(F.lds + MX_QT);
    LAS bf16_t* KT = (LAS bf16_t*)(F.lds + MX_KT);
    LAS bf16_t* KTT = (LAS bf16_t*)(F.lds + MX_KTT);
    LAS bf16_t* VT = (LAS bf16_t*)(F.lds + MX_VT);
    LAS float* EBL = (LAS float*)(F.lds + MX_EBL);
    LAS float* PS = (LAS float*)(F.lds + MX_PS);
    LAS float* AL = (LAS float*)(F.lds + MX_AL);
    LAS float* W2L = (LAS float*)(F.lds + MX_W2);
    const bf16_t* z = F.zb();
    const int b = item >> 2;
    const int hh0 = GLA ? (item & 3) : ((2 * item) & 7);
    const int col = tid & 127, part = __builtin_amdgcn_readfirstlane(tid >> 7);
    const int psq = GLA ? 0 : (col >> 6), pkk = GLA ? col : (col & 63);
    const int phh = hh0 + psq;
    const int rowbase = b * TP + c * 64;
    if (GLA) {
#pragma unroll
        for (int jj = 0; jj < 4; ++jj) W2L[(part * 4 + jj) * 128 + col] = F.in7[(size_t)l * 16 * 512 + (part * 4 + jj) * 512 + phh * 128 + pkk];
        if (tid < 256) ((LAS f32x4*)AL)[tid] = ((const f32x4*)(F.alr() + (size_t)rowbase * 16))[tid];
    }
    {
        const int trow = tid & 15, vc = tid >> 4;
        const int zc = VOFF + (GLA ? hh0 * 256 : hh0 * 128) + vc * 8;
        u32x4 w[4];
#pragma unroll
        for (int p = 0; p < 4; ++p) w[p] = *(const u32x4*)(z + (size_t)(rowbase + trow + 16 * p) * NZ + zc);
#pragma unroll
        for (int p = 0; p < 4; ++p) { const int s = trow + 16 * p; LAS bf16_t* d = VT + (vc * 8) * LDT + s;
            d[0 * LDT] = (bf16_t)(w[p].x & 0xffffu); d[1 * LDT] = (bf16_t)(w[p].x >> 16); d[2 * LDT] = (bf16_t)(w[p].y & 0xffffu); d[3 * LDT] = (bf16_t)(w[p].y >> 16);
            d[4 * LDT] = (bf16_t)(w[p].z & 0xffffu); d[5 * LDT] = (bf16_t)(w[p].z >> 16); d[6 * LDT] = (bf16_t)(w[p].w & 0xffffu); d[7 * LDT] = (bf16_t)(w[p].w >> 16); }
    }
    float qr[16], kr[16];
    {
        const int i32 = pkk & 31;
#pragma unroll
        for (int tt = 0; tt < 16; ++tt) { const size_t zr = (size_t)(rowbase + part * 16 + tt) * NZ;
            if (GLA) { qr[tt] = bf2f(z[zr + QOFF + phh * 128 + pkk]); kr[tt] = bf2f(z[zr + KOFF + phh * 128 + pkk]); }
            else {
                const float q1 = bf2f(z[zr + QOFF + phh * 64 + i32]), q2 = bf2f(z[zr + QOFF + phh * 64 + 32 + i32]);
                const float k1 = bf2f(z[zr + KOFF + phh * 64 + i32]), k2 = bf2f(z[zr + KOFF + phh * 64 + 32 + i32]);
                double rev = (double)(c * 64 + part * 16 + tt) * INVF_REV[i32]; rev -= rint(rev);
                const float sn = __builtin_amdgcn_sinf((float)rev), cs = __builtin_amdgcn_cosf((float)rev);
                if (pkk < 32) { qr[tt] = q1 * cs - q2 * sn; kr[tt] = k1 * cs - k2 * sn; } else { qr[tt] = q1 * sn + q2 * cs; kr[tt] = k1 * sn + k2 * cs; }
            } }
    }
    float bl[16];
    if (GLA) {
        __syncthreads();
        const float bg = F.in8[l * 512 + phh * 128 + pkk];
        float wg2[16];
#pragma unroll
        for (int j = 0; j < 16; ++j) wg2[j] = W2L[j * 128 + col];
        float run = 0.f;
#pragma unroll
        for (int tt = 0; tt < 16; ++tt) { const LAS f32x4* ar = (const LAS f32x4*)(AL + (part * 16 + tt) * 16);
            const f32x4 a0 = ar[0], a1 = ar[1], a2 = ar[2], a3 = ar[3];
            float dot = bg + a0[0] * wg2[0] + a0[1] * wg2[1] + a0[2] * wg2[2] + a0[3] * wg2[3] + a1[0] * wg2[4] + a1[1] * wg2[5] + a1[2] * wg2[6] + a1[3] * wg2[7]
                      + a2[0] * wg2[8] + a2[1] * wg2[9] + a2[2] * wg2[10] + a2[3] * wg2[11] + a3[0] * wg2[12] + a3[1] * wg2[13] + a3[2] * wg2[14] + a3[3] * wg2[15];
            run += logsigmoidf_(dot) * (1.0f / 16.0f); bl[tt] = run; }
        PS[part * 128 + col] = run;
        __syncthreads();
        float off = 0.f, tot = 0.f;
#pragma unroll
        for (int p = 0; p < 4; ++p) { const float v = PS[p * 128 + col]; tot += v; off += (p < part) ? v : 0.f; }
#pragma unroll
        for (int tt = 0; tt < 16; ++tt) bl[tt] += off;
        if (part == 0) EBL[col] = __expf(tot);
    } else {
        const float lg = log1pf(-exp2f(-5.0f - (float)phh));
#pragma unroll
        for (int tt = 0; tt < 16; ++tt) bl[tt] = (float)(part * 16 + tt + 1) * lg;
        if (part == 0) EBL[col] = __expf(64.0f * lg);
    }
    {
        const float qscale = GLA ? 0.08838834764831845f : 0.125f;
        unsigned kp[8];
#pragma unroll
        for (int tt = 0; tt < 16; ++tt) { const int t = part * 16 + tt;
            const float e = __expf(bl[tt]), einv = __expf(-bl[tt]);
            const bf16_t qb = f2bf(qr[tt] * qscale * e), kb_ = f2bf(kr[tt] * einv);
            QT[(psq * 64 + t) * LDQ + pkk] = qb; KT[(psq * 64 + t) * LDQ + pkk] = kb_;
            if (tt & 1) kp[tt >> 1] |= ((unsigned)kb_) << 16; else kp[tt >> 1] = kb_; }
        LAS u32x4* d = (LAS u32x4*)(KTT + (psq * DK + pkk) * LDT + part * 16);
        d[0] = (u32x4){kp[0], kp[1], kp[2], kp[3]}; d[1] = (u32x4){kp[4], kp[5], kp[6], kp[7]};
    }
    __syncthreads();
    {
        u32x4* g = (u32x4*)(F.ws + WS_IMG + ((size_t)((GLA ? 0 : 512) + item * 32 + c)) * IMG_BYTES);
        const LAS u32x4* sI = (const LAS u32x4*)F.lds;
        for (int i = tid; i < IMG_BYTES / 16; i += 512) g[i] = sI[i];
    }
    __syncthreads();
}

template <bool GLA>
DI void mix_seq_prompt(const Ctx& F, int l, int item, int sub) {
    constexpr int DK = GLA ? 128 : 64, DV = GLA ? 256 : 128, KB = DK / 32;
    constexpr int LDQ = DK + 8, LDT = MX_LDT;
    constexpr int NCH = GLA ? 73 : 46, NCHP = GLA ? 80 : 48, BUFB = NCH * 1024;
    constexpr int C_KT = GLA ? 18432 : 9216, C_KTT = GLA ? 36864 : 18432, C_VT = GLA ? 55296 : 27648, C_EBL = GLA ? 73728 : 46080;
    int tid_ = F.tid; asm volatile("" : "+v"(tid_));
    const int tid = tid_, lane = tid & 63, wave = __builtin_amdgcn_readfirstlane(tid >> 6);
    const int b = item >> 2;
    const int hh = GLA ? (item & 3) : ((2 * item) & 7) + sub;
    const bool active = wave < 4;
    const int vs = wave & 3, r = lane & 31, h = lane >> 5;
    f32x16 S[KB];
#pragma unroll
    for (int kb = 0; kb < KB; ++kb)
#pragma unroll
        for (int i = 0; i < 16; ++i) S[kb][i] = 0.f;
    const unsigned char* img0 = F.ws + WS_IMG + ((size_t)((GLA ? 0 : 512) + item * 32)) * IMG_BYTES;
#define MX_SRC(j) (GLA ? ((j) < 54 ? (j) : ((j) < 72 ? 54 + sub * 18 + ((j) - 54) : 90)) \
                       : ((j) < 9 ? sub * 9 + (j) : ((j) < 18 ? 18 + sub * 9 + ((j) - 9) : ((j) < 27 ? 36 + sub * 9 + ((j) - 18) : ((j) < 45 ? 54 + sub * 18 + ((j) - 27) : 90)))))
#define MX_DMA(cc) do { const unsigned char* gsrc = img0 + (size_t)(cc) * IMG_BYTES + lane * 16; LAS unsigned char* dbuf = F.lds + ((cc) & 1) * BUFB; \
        for (int jj = wave; jj < NCHP; jj += 8) { const int j = jj < NCH ? jj : NCH - 1; \
            __builtin_amdgcn_global_load_lds((const unsigned*)(gsrc + MX_SRC(j) * 1024), (LAS unsigned*)(dbuf + j * 1024), 16, 0, 0); } } while (0)
    MX_DMA(0);
    for (int c = 0; c < 32; ++c) {
        const int rowbase = b * TP + c * 64;
        asm volatile("s_waitcnt vmcnt(0)" ::: "memory");
        __syncthreads();
        if (c + 1 < 32) MX_DMA(c + 1);
        if (active) {
        LAS unsigned char* base = F.lds + (c & 1) * BUFB;
        const LAS bf16_t* QTs = (const LAS bf16_t*)base; const LAS bf16_t* KTs = (const LAS bf16_t*)(base + C_KT);
        const LAS bf16_t* KTTs = (const LAS bf16_t*)(base + C_KTT); const LAS bf16_t* VTs = (const LAS bf16_t*)(base + C_VT) + vs * 32 * LDT;
        const LAS float* EBLs = (const LAS float*)(base + C_EBL) + (GLA ? 0 : sub * 64);
        f32x16 o0, o1, p00, p01, p11;
#pragma unroll
        for (int i = 0; i < 16; ++i) { p00[i] = 0.f; p01[i] = 0.f; p11[i] = 0.f; o0[i] = 0.f; o1[i] = 0.f; }
        constexpr int NG = DK / 32;
        bf16x8 ka[2][2][2], qb[2][2][2];
        s16x4 ql[2][2][2][2];
        s16x4 vl[2][2][2];
        bf16x8 vb[2], kaS[2][KB];
#define SQ_SB __builtin_amdgcn_sched_barrier(0)
#define LD_PT(bf, g) do { _Pragma("unroll") for (int q_ = 0; q_ < 2; ++q_) { const int ko = ((g) * 2 + q_) * 16 + 8 * h; \
            ka[bf][q_][0] = *(const LAS bf16x8*)(KTs + r * LDQ + ko); ka[bf][q_][1] = *(const LAS bf16x8*)(KTs + (32 + r) * LDQ + ko); \
            qb[bf][q_][0] = *(const LAS bf16x8*)(QTs + r * LDQ + ko); qb[bf][q_][1] = *(const LAS bf16x8*)(QTs + (32 + r) * LDQ + ko); } } while (0)
#define MM_PT(bf) do { _Pragma("unroll") for (int q_ = 0; q_ < 2; ++q_) { p00 = MFMA32(ka[bf][q_][0], qb[bf][q_][0], p00); p01 = MFMA32(ka[bf][q_][0], qb[bf][q_][1], p01); p11 = MFMA32(ka[bf][q_][1], qb[bf][q_][1], p11); } } while (0)
#define LD_OI(bf, kb) do { _Pragma("unroll") for (int s2 = 0; s2 < 2; ++s2) { const int kbase = (kb) * 32 + 16 * s2 + 4 * h; \
            ql[bf][s2][0][0] = *(const LAS s16x4*)(QTs + r * LDQ + kbase); ql[bf][s2][0][1] = *(const LAS s16x4*)(QTs + r * LDQ + kbase + 8); \
            ql[bf][s2][1][0] = *(const LAS s16x4*)(QTs + (32 + r) * LDQ + kbase); ql[bf][s2][1][1] = *(const LAS s16x4*)(QTs + (32 + r) * LDQ + kbase + 8); } } while (0)
#define MM_OI(bf, kb) do { _Pragma("unroll") for (int s2 = 0; s2 < 2; ++s2) { const bf16x8 xs = pack_step(S[kb], s2); \
            o0 = MFMA32(cat4(ql[bf][s2][0][0], ql[bf][s2][0][1]), xs, o0); o1 = MFMA32(cat4(ql[bf][s2][1][0], ql[bf][s2][1][1]), xs, o1); } } while (0)
#define LD_SU(bf, s16) do { vb[bf] = *(const LAS bf16x8*)(VTs + r * LDT + (s16) * 16 + 8 * h); \
            _Pragma("unroll") for (int kb = 0; kb < KB; ++kb) kaS[bf][kb] = *(const LAS bf16x8*)(KTTs + (kb * 32 + r) * LDT + (s16) * 16 + 8 * h); } while (0)
#define MM_SU(bf) do { _Pragma("unroll") for (int kb = 0; kb < KB; ++kb) S[kb] = MFMA32(kaS[bf][kb], vb[bf], S[kb]); } while (0)
        LD_PT(0, 0); SQ_SB;
#pragma unroll
        for (int g = 0; g < NG; ++g) {
            if (g + 1 < NG) LD_PT((g + 1) & 1, g + 1); else LD_OI(0, 0);
            SQ_SB; MM_PT(g & 1); SQ_SB;
        }
#pragma unroll
        for (int i = 0; i < 16; ++i) { const bool keep = crow(i, h) <= r; p00[i] = keep ? p00[i] : 0.f; p11[i] = keep ? p11[i] : 0.f; }
#pragma unroll
        for (int kb = 0; kb < KB; ++kb) {
            if (kb + 1 < KB) LD_OI((kb + 1) & 1, kb + 1);
            else {
#pragma unroll
                for (int s2 = 0; s2 < 2; ++s2) { const int sb0 = 16 * s2 + 4 * h, sb1 = 32 + 16 * s2 + 4 * h;
                    vl[s2][0][0] = *(const LAS s16x4*)(VTs + r * LDT + sb0); vl[s2][0][1] = *(const LAS s16x4*)(VTs + r * LDT + sb0 + 8);
                    vl[s2][1][0] = *(const LAS s16x4*)(VTs + r * LDT + sb1); vl[s2][1][1] = *(const LAS s16x4*)(VTs + r * LDT + sb1 + 8); }
            }
            SQ_SB; MM_OI(kb & 1, kb); SQ_SB;
        }
        LD_SU(0, 0); SQ_SB;
#pragma unroll
        for (int s2 = 0; s2 < 2; ++s2) {
            const bf16x8 vb0 = cat4(vl[s2][0][0], vl[s2][0][1]), vb1 = cat4(vl[s2][1][0], vl[s2][1][1]);
            o0 = MFMA32(pack_step(p00, s2), vb0, o0); o1 = MFMA32(pack_step(p01, s2), vb0, o1); o1 = MFMA32(pack_step(p11, s2), vb1, o1);
        }
        SQ_SB;
#pragma unroll
        for (int s16 = 0; s16 < 4; ++s16) {
            if (s16 + 1 < 4) LD_SU((s16 + 1) & 1, s16 + 1);
            SQ_SB; MM_SU(s16 & 1); SQ_SB;
        }
#undef LD_PT
#undef MM_PT
#undef LD_OI
#undef MM_OI
#undef LD_SU
#undef MM_SU
#undef SQ_SB
        {
            float eb[KB][16];
#pragma unroll
            for (int kb = 0; kb < KB; ++kb)
#pragma unroll
                for (int i = 0; i < 16; ++i) eb[kb][i] = EBLs[kb * 32 + crow(i, h)];
#pragma unroll
            for (int kb = 0; kb < KB; ++kb)
#pragma unroll
                for (int i = 0; i < 16; ++i) S[kb][i] *= eb[kb][i];
        }
        {
            bf16_t* ob = F.ocat() + (size_t)(rowbase + 4 * h) * 3072 + (GLA ? hh * 256 + sub * 128 : 1024 + hh * 128) + vs * 32 + r;
#pragma unroll
            for (int i = 0; i < 16; ++i) { const int tr = (i & 3) + 8 * (i >> 2);
                ob[(size_t)tr * 3072] = f2bf(o0[i]); ob[(size_t)(32 + tr) * 3072] = f2bf(o1[i]); }
        }
        }
    }
#undef MX_DMA
#undef MX_SRC
    if (active) {
        int lofs = 4 * h * DV + (GLA ? sub * 128 : 0) + vs * 32 + r;
        asm volatile("" : "+v"(lofs));
        float* so = (GLA ? F.out + O_GLAP + ((size_t)(l * 4 + b) * 4 + hh) * (128 * 256) : F.out + O_RETP + ((size_t)(l * 4 + b) * 8 + hh) * (64 * 128)) + lofs;
#pragma unroll
        for (int kb = 0; kb < KB; ++kb)
#pragma unroll
            for (int i = 0; i < 16; ++i) so[(kb * 32 + (i & 3) + 8 * (i >> 2)) * DV] = S[kb][i];
    }
    asm volatile("s_waitcnt vmcnt(0)" ::: "memory");
    __syncthreads();
}

template <bool GLA>
DI void mix_sample(const Ctx& F, int l, int item) {
    constexpr int DK = GLA ? 128 : 64, DV = GLA ? 256 : 128, NHD = GLA ? 4 : 8;
    constexpr int LPR = DV / 4, NG = 512 / LPR, KPG = DK / NG;
    constexpr int QOFF = GLA ? ZQA : ZQR, KOFF = GLA ? ZKA : ZKR, VOFF = GLA ? ZVA : ZVR, GOFF = GLA ? ZRA : ZGR;
    int tid_ = F.tid; asm volatile("" : "+v"(tid_));
    const int tid = tid_, lane = tid & 63, wave = __builtin_amdgcn_readfirstlane(tid >> 6);
    LAS float* QS = (LAS float*)(F.lds + 0);
    LAS float* KS = (LAS float*)(F.lds + 2048);
    LAS float* EB = (LAS float*)(F.lds + 4096);
    LAS float* VS = (LAS float*)(F.lds + 4608);
    LAS float* PL = (LAS float*)(F.lds + 8704);
    LAS float* OR = (LAS float*)(F.lds + 9216);
    const bf16_t* z = F.zb();
    const int b = item / NHD, hh = item % NHD;
    const int row0 = MP + b * 4;
    const int lq_ = GLA ? lane : (lane & 31);
    u32x2 gw_pre = {0u, 0u}; f32x4 pg_pre = {0.f, 0.f, 0.f, 0.f}, pb_pre = {0.f, 0.f, 0.f, 0.f};
    if (wave < 4) {
        gw_pre = *(const u32x2*)(z + (size_t)(row0 + wave) * NZ + GOFF + hh * DV + lq_ * 4);
        if (GLA) pg_pre = *(const f32x4*)(F.in9 + l * 1024 + hh * 256 + lq_ * 4);
        else { pg_pre = *(const f32x4*)(F.in10 + l * 1024 + hh * 128 + lq_ * 4); pb_pre = *(const f32x4*)(F.in11 + l * 1024 + hh * 128 + lq_ * 4); }
    }
    if (tid < DK) {
        const int kk = tid;
        if (GLA) {
            float wg2[16];
#pragma unroll
            for (int j = 0; j < 16; ++j) wg2[j] = F.in7[(size_t)l * 16 * 512 + j * 512 + hh * 128 + kk];
            const float bg = F.in8[l * 512 + hh * 128 + kk];
            float run = 0.f;
#pragma unroll
            for (int t = 0; t < 4; ++t) { const float* ar = F.alr() + (size_t)(row0 + t) * 16; float dot = bg;
#pragma unroll
                for (int j = 0; j < 16; ++j) dot += ar[j] * wg2[j];
                run += logsigmoidf_(dot) * (1.0f / 16.0f);
                const size_t zr = (size_t)(row0 + t) * NZ;
                QS[t * DK + kk] = bf2f(z[zr + QOFF + hh * 128 + kk]) * 0.08838834764831845f * __expf(run);
                KS[t * DK + kk] = bf2f(z[zr + KOFF + hh * 128 + kk]) * __expf(-run); }
            EB[kk] = __expf(run);
        } else {
            const float lg = log1pf(-exp2f(-5.0f - (float)hh));
            const double inv_freq = INVF_REV[kk & 31];
            const int i32 = kk & 31;
#pragma unroll
            for (int t = 0; t < 4; ++t) { const size_t zr = (size_t)(row0 + t) * NZ;
                const float q1 = bf2f(z[zr + QOFF + hh * 64 + i32]), q2 = bf2f(z[zr + QOFF + hh * 64 + 32 + i32]);
                const float k1 = bf2f(z[zr + KOFF + hh * 64 + i32]), k2 = bf2f(z[zr + KOFF + hh * 64 + 32 + i32]);
                double rev = (double)(16384 + t) * inv_freq; rev -= rint(rev);
                const float sn = __builtin_amdgcn_sinf((float)rev), cs = __builtin_amdgcn_cosf((float)rev);
                float qv, kv;
                if (kk < 32) { qv = q1 * cs - q2 * sn; kv = k1 * cs - k2 * sn; } else { qv = q1 * sn + q2 * cs; kv = k1 * sn + k2 * cs; }
                const float bt = (float)(t + 1) * lg;
                QS[t * DK + kk] = qv * 0.125f * __expf(bt); KS[t * DK + kk] = kv * __expf(-bt); }
            EB[kk] = __expf(4.0f * lg);
        }
    }
    if (tid < DV) {
#pragma unroll
        for (int t = 0; t < 4; ++t) VS[t * DV + tid] = bf2f(z[(size_t)(row0 + t) * NZ + VOFF + hh * DV + tid]);
    }
    __syncthreads();
    {
        const int pair = tid >> 5, sub = tid & 31, t = pair >> 2, s = pair & 3;
        float p = 0.f;
#pragma unroll
        for (int i = 0; i < DK / 32; ++i) p += QS[t * DK + sub + 32 * i] * KS[s * DK + sub + 32 * i];
#pragma unroll
        for (int o = 16; o >= 1; o >>= 1) p += __shfl_xor(p, o);
        if (sub == 0) PL[pair] = (s <= t) ? p : 0.f;
    }
    const int lv = tid % LPR, grp = tid / LPR;
    f32x4 vr[4];
#pragma unroll
    for (int s = 0; s < 4; ++s) vr[s] = *(const LAS f32x4*)(VS + s * DV + lv * 4);
    {
        const size_t sbase = GLA ? ((size_t)(l * 128 + b) * 4 + hh) * (128 * 256) : ((size_t)(l * 128 + b) * 8 + hh) * (64 * 128);
        const float* sin_ = (GLA ? F.in2 : F.in3) + sbase;
        float* sout = F.out + (GLA ? O_GLAS : O_RETS) + sbase;
        constexpr int KBATCH = KPG;
        f32x4 oa[4];
#pragma unroll
        for (int t = 0; t < 4; ++t) oa[t] = (f32x4){0.f, 0.f, 0.f, 0.f};
#pragma unroll 1
        for (int k0 = 0; k0 < KPG; k0 += KBATCH) {
            f32x4 st[KBATCH];
#pragma unroll
            for (int kk = 0; kk < KBATCH; ++kk) st[kk] = *(const f32x4*)(sin_ + (size_t)(grp * KPG + k0 + kk) * DV + lv * 4);
#pragma unroll
            for (int kk = 0; kk < KBATCH; ++kk) { const int k = grp * KPG + k0 + kk; f32x4 sv = st[kk];
#pragma unroll
                for (int t = 0; t < 4; ++t) oa[t] += sv * QS[t * DK + k];
#pragma unroll
                for (int s = 0; s < 4; ++s) sv += vr[s] * KS[s * DK + k];
                sv = sv * EB[k];
                *(f32x4*)(sout + (size_t)k * DV + lv * 4) = sv; }
        }
#pragma unroll
        for (int t = 0; t < 4; ++t) *(LAS f32x4*)(OR + (grp * 4 + t) * DV + lv * 4) = oa[t];
    }
    __syncthreads();
    if (wave < 4) {
        const int t = wave, lq = GLA ? lane : (lane & 31);
        f32x4 ov = {0.f, 0.f, 0.f, 0.f};
#pragma unroll
        for (int g = 0; g < NG; ++g) ov += *(const LAS f32x4*)(OR + (g * 4 + t) * DV + lq * 4);
#pragma unroll
        for (int s = 0; s < 4; ++s) ov += *(const LAS f32x4*)(VS + s * DV + lq * 4) * PL[t * 4 + s];
        const size_t row = (size_t)(row0 + t);
        const u32x2 gw = gw_pre;
        const f32x4 gt = {bflo(gw.x), bfhi(gw.x), bflo(gw.y), bfhi(gw.y)};
        f32x4 y;
        if (GLA) {
            const f32x4 pg = pg_pre;
            float ss = ov[0] * ov[0] + ov[1] * ov[1] + ov[2] * ov[2] + ov[3] * ov[3]; ss = wave_sum(ss);
            const float rstd = rsqrtf(ss * (1.0f / 256.0f) + 1e-6f);
            y = ov * rstd * pg;
        } else {
            const f32x4 pg = pg_pre, pb2 = pb_pre;
            float s1 = ov[0] + ov[1] + ov[2] + ov[3];
#pragma unroll
            for (int o = 16; o >= 1; o >>= 1) s1 += __shfl_xor(s1, o);
            const float mu = s1 * (1.0f / 128.0f);
            const f32x4 dv = ov - mu;
            float s2 = dv[0] * dv[0] + dv[1] * dv[1] + dv[2] * dv[2] + dv[3] * dv[3];
#pragma unroll
            for (int o = 16; o >= 1; o >>= 1) s2 += __shfl_xor(s2, o);
            const float rstd = rsqrtf(s2 * (1.0f / 128.0f) + 1e-5f);
            y = dv * rstd * pg + pb2;
        }
        y[0] *= siluf_(gt[0]); y[1] *= siluf_(gt[1]); y[2] *= siluf_(gt[2]); y[3] *= siluf_(gt[3]);
        u32x2 w; w.x = pk2(y[0], y[1]); w.y = pk2(y[2], y[3]);
        if (GLA || lane < 32) *(u32x2*)(F.ocat() + row * 3072 + (GLA ? 0 : 1024) + hh * DV + lq * 4) = w;
    }
    __syncthreads();
}

template <bool GLA>
DI void mix_sample_wave(const Ctx& F, int l, int item, int lane) {
    constexpr int DK = GLA ? 128 : 64, DV = GLA ? 256 : 128, NHD = GLA ? 4 : 8, NK = DK / 64, VW = DV / 64;
    constexpr int QOFF = GLA ? ZQA : ZQR, KOFF = GLA ? ZKA : ZKR, VOFF = GLA ? ZVA : ZVR, GOFF = GLA ? ZRA : ZGR;
    const bf16_t* z = F.zb();
    const int b = item / NHD, hh = item % NHD;
    const int row0 = MP + b * 4;
    float qs[4][NK], ks[4][NK], eb[NK];
    if (GLA) {
#pragma unroll
        for (int j = 0; j < NK; ++j) { const int k = lane + 64 * j;
            float w2[16];
#pragma unroll
            for (int jj = 0; jj < 16; ++jj) w2[jj] = F.in7[(size_t)l * 16 * 512 + jj * 512 + hh * 128 + k];
            const float bg = F.in8[l * 512 + hh * 128 + k];
            float run = 0.f;
#pragma unroll
            for (int t = 0; t < 4; ++t) { const float* ar = F.alr() + (size_t)(row0 + t) * 16; float dot = bg;
#pragma unroll
                for (int jj = 0; jj < 16; ++jj) dot += ar[jj] * w2[jj];
                run += logsigmoidf_(dot) * (1.0f / 16.0f);
                const size_t zr = (size_t)(row0 + t) * NZ;
                qs[t][j] = bf2f(z[zr + QOFF + hh * 128 + k]) * 0.08838834764831845f * __expf(run);
                ks[t][j] = bf2f(z[zr + KOFF + hh * 128 + k]) * __expf(-run); }
            eb[j] = __expf(run); }
    } else {
        const float lg = log1pf(-exp2f(-5.0f - (float)hh));
        const int i32 = lane & 31;
        const double inv_freq = INVF_REV[i32];
#pragma unroll
        for (int t = 0; t < 4; ++t) { const size_t zr = (size_t)(row0 + t) * NZ;
            const float q1 = bf2f(z[zr + QOFF + hh * 64 + i32]), q2 = bf2f(z[zr + QOFF + hh * 64 + 32 + i32]);
            const float k1 = bf2f(z[zr + KOFF + hh * 64 + i32]), k2 = bf2f(z[zr + KOFF + hh * 64 + 32 + i32]);
            double rev = (double)(16384 + t) * inv_freq; rev -= rint(rev);
            const float sn = __builtin_amdgcn_sinf((float)rev), cs = __builtin_amdgcn_cosf((float)rev);
            float qv, kv;
            if (lane < 32) { qv = q1 * cs - q2 * sn; kv = k1 * cs - k2 * sn; } else { qv = q1 * sn + q2 * cs; kv = k1 * sn + k2 * cs; }
            const float bt = (float)(t + 1) * lg;
            qs[t][0] = qv * 0.125f * __expf(bt); ks[t][0] = kv * __expf(-bt); }
        eb[0] = __expf(4.0f * lg);
    }
    float vv[4][VW], gt[4][VW], gn[VW], gbias[VW];
#pragma unroll
    for (int t = 0; t < 4; ++t) { const size_t zr = (size_t)(row0 + t) * NZ;
        if (GLA) { const u32x2 w = *(const u32x2*)(z + zr + VOFF + hh * DV + lane * VW), g = *(const u32x2*)(z + zr + GOFF + hh * DV + lane * VW);
            vv[t][0] = bflo(w.x); vv[t][1] = bfhi(w.x); vv[t][VW - 2] = bflo(w.y); vv[t][VW - 1] = bfhi(w.y);
            gt[t][0] = bflo(g.x); gt[t][1] = bfhi(g.x); gt[t][VW - 2] = bflo(g.y); gt[t][VW - 1] = bfhi(g.y); }
        else { const unsigned w = *(const unsigned*)(z + zr + VOFF + hh * DV + lane * VW), g = *(const unsigned*)(z + zr + GOFF + hh * DV + lane * VW);
            vv[t][0] = bflo(w); vv[t][1] = bfhi(w); gt[t][0] = bflo(g); gt[t][1] = bfhi(g); } }
#pragma unroll
    for (int e = 0; e < VW; ++e) { gn[e] = (GLA ? F.in9 : F.in10)[l * 1024 + hh * DV + lane * VW + e]; gbias[e] = GLA ? 0.f : F.in11[l * 1024 + hh * DV + lane * VW + e]; }
    float P[4][4];
#pragma unroll
    for (int t = 0; t < 4; ++t)
#pragma unroll
        for (int s2 = 0; s2 < 4; ++s2) { if (s2 <= t) { float p = 0.f;
#pragma unroll
                for (int j = 0; j < NK; ++j) p += qs[t][j] * ks[s2][j];
                P[t][s2] = wave_sum(p); } else P[t][s2] = 0.f; }
    const size_t sbase = GLA ? ((size_t)(l * 128 + b) * 4 + hh) * (128 * 256) : ((size_t)(l * 128 + b) * 8 + hh) * (64 * 128);
    const float* sin_ = (GLA ? F.in2 : F.in3) + sbase + lane * VW;
    float* sout = F.out + (GLA ? O_GLAS : O_RETS) + sbase + lane * VW;
    float o[4][VW];
#pragma unroll
    for (int t = 0; t < 4; ++t)
#pragma unroll
        for (int e = 0; e < VW; ++e) o[t][e] = 0.f;
    typedef float fvw __attribute__((ext_vector_type(VW)));
#pragma unroll
    for (int j = 0; j < NK; ++j) {
#pragma unroll 1
        for (int k0 = 0; k0 < 64; k0 += 16) {
            fvw st[16];
#pragma unroll
            for (int kk = 0; kk < 16; ++kk) st[kk] = *(const fvw*)(sin_ + (size_t)(j * 64 + k0 + kk) * DV);
#pragma unroll
            for (int kk = 0; kk < 16; ++kk) { const int kl = k0 + kk;
                fvw sv = st[kk];
                float qk[4], kq[4];
#pragma unroll
                for (int t = 0; t < 4; ++t) { qk[t] = __builtin_bit_cast(float, __builtin_amdgcn_readlane(__builtin_bit_cast(int, qs[t][j]), kl));
                                              kq[t] = __builtin_bit_cast(float, __builtin_amdgcn_readlane(__builtin_bit_cast(int, ks[t][j]), kl)); }
                const float ebk = GLA ? __builtin_bit_cast(float, __builtin_amdgcn_readlane(__builtin_bit_cast(int, eb[j]), kl)) : eb[0];
#pragma unroll
                for (int e = 0; e < VW; ++e) {
#pragma unroll
                    for (int t = 0; t < 4; ++t) o[t][e] += qk[t] * sv[e];
                    float a = sv[e];
#pragma unroll
                    for (int t = 0; t < 4; ++t) a += kq[t] * vv[t][e];
                    sv[e] = a * ebk; }
                *(fvw*)(sout + (size_t)(j * 64 + kl) * DV) = sv; }
        }
    }
#pragma unroll
    for (int t = 0; t < 4; ++t) {
        float of[VW];
#pragma unroll
        for (int e = 0; e < VW; ++e) { float a = o[t][e];
#pragma unroll
            for (int s2 = 0; s2 < 4; ++s2) a += P[t][s2] * vv[s2][e];
            of[e] = a; }
        float y[VW];
        if (GLA) {
            float ss = 0.f;
#pragma unroll
            for (int e = 0; e < VW; ++e) ss += of[e] * of[e];
            ss = wave_sum(ss);
            const float rstd = rsqrtf(ss * (1.0f / 256.0f) + 1e-6f);
#pragma unroll
            for (int e = 0; e < VW; ++e) y[e] = of[e] * rstd * gn[e];
        } else {
            float s1 = 0.f;
#pragma unroll
            for (int e = 0; e < VW; ++e) s1 += of[e];
            const float mu = wave_sum(s1) * (1.0f / 128.0f);
            float sq = 0.f;
#pragma unroll
            for (int e = 0; e < VW; ++e) { of[e] -= mu; sq += of[e] * of[e]; }
            const float rstd = rsqrtf(wave_sum(sq) * (1.0f / 128.0f) + 1e-5f);
#pragma unroll
            for (int e = 0; e < VW; ++e) y[e] = of[e] * rstd * gn[e] + gbias[e];
        }
#pragma unroll
        for (int e = 0; e < VW; ++e) y[e] *= siluf_(gt[t][e]);
        bf16_t* op = F.ocat() + (size_t)(row0 + t) * 3072 + (GLA ? 0 : 1024) + hh * DV + lane * VW;
        if (GLA) { u32x2 w; w.x = pk2(y[0], y[1]); w.y = pk2(y[VW - 2], y[VW - 1]); *(u32x2*)op = w; }
        else *(unsigned*)op = pk2(y[0], y[1]);
    }
}

DI void mix_conv(const Ctx& F, int l, int item) {
    const bf16_t* z = F.zb();
    const float* cw = F.in12 + (size_t)l * 3 * 1024;
#pragma unroll 1
    for (int i = 0; i < 4; ++i) {
        int tid_ = F.tid; asm volatile("" : "+v"(tid_));
        const int p = tid_ + 512 * i, oct = p & 127, run = p >> 7, c = oct * 8;
        const int rs = item * 64 + run * 4;
        float w0[8], w1[8], w2[8], u0[8], u1[8];
        { const f32x4 a = *(const f32x4*)(cw + c), b = *(const f32x4*)(cw + c + 4); w0[0] = a[0]; w0[1] = a[1]; w0[2] = a[2]; w0[3] = a[3]; w0[4] = b[0]; w0[5] = b[1]; w0[6] = b[2]; w0[7] = b[3]; }
        { const f32x4 a = *(const f32x4*)(cw + 1024 + c), b = *(const f32x4*)(cw + 1024 + c + 4); w1[0] = a[0]; w1[1] = a[1]; w1[2] = a[2]; w1[3] = a[3]; w1[4] = b[0]; w1[5] = b[1]; w1[6] = b[2]; w1[7] = b[3]; }
        { const f32x4 a = *(const f32x4*)(cw + 2048 + c), b = *(const f32x4*)(cw + 2048 + c + 4); w2[0] = a[0]; w2[1] = a[1]; w2[2] = a[2]; w2[3] = a[3]; w2[4] = b[0]; w2[5] = b[1]; w2[6] = b[2]; w2[7] = b[3]; }
        const bool prompt = rs < MP;
        const int t0 = prompt ? (rs & (TP - 1)) : 0;
        const int bb = prompt ? (rs >> 11) : ((rs - MP) >> 2);
        if (prompt) {
            if (t0 == 0) {
#pragma unroll
                for (int e = 0; e < 8; ++e) { u0[e] = 0.f; u1[e] = 0.f; }
            } else {
#pragma unroll
                for (int j = 0; j < 2; ++j) { const size_t zr = (size_t)(rs - 2 + j) * NZ;
                    const u32x4 cc = *(const u32x4*)(z + zr + ZCC + c), ch = *(const u32x4*)(z + zr + ZCH + c);
                    float* u = j ? u1 : u0;
                    u[0] = bflo(cc.x) * bflo(ch.x); u[1] = bfhi(cc.x) * bfhi(ch.x); u[2] = bflo(cc.y) * bflo(ch.y); u[3] = bfhi(cc.y) * bfhi(ch.y);
                    u[4] = bflo(cc.z) * bflo(ch.z); u[5] = bfhi(cc.z) * bfhi(ch.z); u[6] = bflo(cc.w) * bflo(ch.w); u[7] = bfhi(cc.w) * bfhi(ch.w); }
            }
        } else {
            const float* sc = F.in4 + ((size_t)(l * 128 + bb) * 2) * 1024 + c;
            { const f32x4 a = *(const f32x4*)(sc), b = *(const f32x4*)(sc + 4); u0[0] = a[0]; u0[1] = a[1]; u0[2] = a[2]; u0[3] = a[3]; u0[4] = b[0]; u0[5] = b[1]; u0[6] = b[2]; u0[7] = b[3]; }
            { const f32x4 a = *(const f32x4*)(sc + 1024), b = *(const f32x4*)(sc + 1024 + 4); u1[0] = a[0]; u1[1] = a[1]; u1[2] = a[2]; u1[3] = a[3]; u1[4] = b[0]; u1[5] = b[1]; u1[6] = b[2]; u1[7] = b[3]; }
        }
        const bool last_run = prompt ? (t0 + 4 == TP) : true;
        float* nc = prompt ? F.out + O_CONVP + ((size_t)(l * 4 + bb) * 2) * 1024 + c : F.out + O_CONVS + ((size_t)(l * 128 + bb) * 2) * 1024 + c;
#pragma unroll
        for (int t = 0; t < 4; ++t) { const size_t row = (size_t)(rs + t); const size_t zr = row * NZ;
            const u32x4 cc = *(const u32x4*)(z + zr + ZCC + c), ch = *(const u32x4*)(z + zr + ZCH + c), cb = *(const u32x4*)(z + zr + ZCB + c);
            float u[8], bq[8], y[8];
            u[0] = bflo(cc.x) * bflo(ch.x); u[1] = bfhi(cc.x) * bfhi(ch.x); u[2] = bflo(cc.y) * bflo(ch.y); u[3] = bfhi(cc.y) * bfhi(ch.y);
            u[4] = bflo(cc.z) * bflo(ch.z); u[5] = bfhi(cc.z) * bfhi(ch.z); u[6] = bflo(cc.w) * bflo(ch.w); u[7] = bfhi(cc.w) * bfhi(ch.w);
            bq[0] = bflo(cb.x); bq[1] = bfhi(cb.x); bq[2] = bflo(cb.y); bq[3] = bfhi(cb.y); bq[4] = bflo(cb.z); bq[5] = bfhi(cb.z); bq[6] = bflo(cb.w); bq[7] = bfhi(cb.w);
#pragma unroll
            for (int e = 0; e < 8; ++e) y[e] = bq[e] * (w0[e] * u0[e] + w1[e] * u1[e] + w2[e] * u[e]);
            u32x4 w; w.x = pk2(y[0], y[1]); w.y = pk2(y[2], y[3]); w.z = pk2(y[4], y[5]); w.w = pk2(y[6], y[7]);
            *(u32x4*)(F.ocat() + row * 3072 + 2048 + c) = w;
            if (last_run && t >= 2) { float* d = nc + (size_t)(t - 2) * 1024;
                *(f32x4*)d = (f32x4){u[0], u[1], u[2], u[3]}; *(f32x4*)(d + 4) = (f32x4){u[4], u[5], u[6], u[7]}; }
#pragma unroll
            for (int e = 0; e < 8; ++e) { u0[e] = u1[e]; u1[e] = u[e]; } }
    }
}

DI void phase_post(const Ctx& F, int l) {
    const int lane = F.lane, wave = F.wave;
    const bf16_t* z = F.zb();
    float gg[16], rw[16], rb[16];
#pragma unroll
    for (int e = 0; e < 16; ++e) { gg[e] = F.in9[l * 1024 + lane * 16 + e]; rw[e] = F.in10[l * 1024 + lane * 16 + e]; rb[e] = F.in11[l * 1024 + lane * 16 + e]; }
    for (int row = F.blk * 8 + wave; row < MP; row += F.G * 8) {
        bf16_t* orow = F.ocat() + (size_t)row * 3072;
        const bf16_t* zrow = z + (size_t)row * NZ;
#pragma unroll
        for (int part = 0; part < 2; ++part) {
            const u32x4 o0 = *(const u32x4*)(orow + part * 1024 + lane * 16), o1 = *(const u32x4*)(orow + part * 1024 + lane * 16 + 8);
            const u32x4 g0 = *(const u32x4*)(zrow + (part ? ZGR : ZRA) + lane * 16), g1 = *(const u32x4*)(zrow + (part ? ZGR : ZRA) + lane * 16 + 8);
            float v[16], gt[16];
            v[0] = bflo(o0.x); v[1] = bfhi(o0.x); v[2] = bflo(o0.y); v[3] = bfhi(o0.y); v[4] = bflo(o0.z); v[5] = bfhi(o0.z); v[6] = bflo(o0.w); v[7] = bfhi(o0.w);
            v[8] = bflo(o1.x); v[9] = bfhi(o1.x); v[10] = bflo(o1.y); v[11] = bfhi(o1.y); v[12] = bflo(o1.z); v[13] = bfhi(o1.z); v[14] = bflo(o1.w); v[15] = bfhi(o1.w);
            gt[0] = bflo(g0.x); gt[1] = bfhi(g0.x); gt[2] = bflo(g0.y); gt[3] = bfhi(g0.y); gt[4] = bflo(g0.z); gt[5] = bfhi(g0.z); gt[6] = bflo(g0.w); gt[7] = bfhi(g0.w);
            gt[8] = bflo(g1.x); gt[9] = bfhi(g1.x); gt[10] = bflo(g1.y); gt[11] = bfhi(g1.y); gt[12] = bflo(g1.z); gt[13] = bfhi(g1.z); gt[14] = bflo(g1.w); gt[15] = bfhi(g1.w);
            float y[16];
            if (part == 0) {
                float ss = 0.f;
#pragma unroll
                for (int e = 0; e < 16; ++e) ss += v[e] * v[e];
#pragma unroll
                for (int o = 8; o >= 1; o >>= 1) ss += __shfl_xor(ss, o);
                const float rstd = rsqrtf(ss * (1.0f / 256.0f) + 1e-6f);
#pragma unroll
                for (int e = 0; e < 16; ++e) y[e] = v[e] * rstd * gg[e];
            } else {
                float s1 = 0.f;
#pragma unroll
                for (int e = 0; e < 16; ++e) s1 += v[e];
#pragma unroll
                for (int o = 4; o >= 1; o >>= 1) s1 += __shfl_xor(s1, o);
                const float mu = s1 * (1.0f / 128.0f);
                float s2 = 0.f;
#pragma unroll
                for (int e = 0; e < 16; ++e) { v[e] -= mu; s2 += v[e] * v[e]; }
#pragma unroll
                for (int o = 4; o >= 1; o >>= 1) s2 += __shfl_xor(s2, o);
                const float rstd = rsqrtf(s2 * (1.0f / 128.0f) + 1e-5f);
#pragma unroll
                for (int e = 0; e < 16; ++e) y[e] = v[e] * rstd * rw[e] + rb[e];
            }
#pragma unroll
            for (int e = 0; e < 16; ++e) y[e] *= siluf_(gt[e]);
            u32x4 w0, w1;
            w0.x = pk2(y[0], y[1]); w0.y = pk2(y[2], y[3]); w0.z = pk2(y[4], y[5]); w0.w = pk2(y[6], y[7]);
            w1.x = pk2(y[8], y[9]); w1.y = pk2(y[10], y[11]); w1.z = pk2(y[12], y[13]); w1.w = pk2(y[14], y[15]);
            *(u32x4*)(orow + part * 1024 + lane * 16) = w0; *(u32x4*)(orow + part * 1024 + lane * 16 + 8) = w1;
        }
    }
    __syncthreads();
}
DI void phase_merge(const Ctx& F) {
    const int lane = F.lane, wave = F.wave;
    const bf16_t* z = F.zb(); const bf16_t* P = F.pbr(); bf16_t* mo = F.mb();
    for (int row = F.blk * 8 + wave; row < MROWS; row += F.G * 8) {
        const bf16_t* pr = P + (size_t)row * (3 * D); const bf16_t* gr = z + (size_t)row * NZ + ZGATE;
#pragma unroll
        for (int q = 0; q < 4; ++q) { const int c = q * 512 + lane * 8;
            float acc[8];
#pragma unroll
            for (int e = 0; e < 8; ++e) acc[e] = 0.f;
#pragma unroll
            for (int br = 0; br < 3; ++br) { const u32x4 pw = *(const u32x4*)(pr + br * D + c), gw = *(const u32x4*)(gr + br * D + c);
                acc[0] += sigmoidf_(bflo(gw.x)) * bflo(pw.x); acc[1] += sigmoidf_(bfhi(gw.x)) * bfhi(pw.x); acc[2] += sigmoidf_(bflo(gw.y)) * bflo(pw.y); acc[3] += sigmoidf_(bfhi(gw.y)) * bfhi(pw.y);
                acc[4] += sigmoidf_(bflo(gw.z)) * bflo(pw.z); acc[5] += sigmoidf_(bfhi(gw.z)) * bfhi(pw.z); acc[6] += sigmoidf_(bflo(gw.w)) * bflo(pw.w); acc[7] += sigmoidf_(bfhi(gw.w)) * bfhi(pw.w); }
            u32x4 w; w.x = pk2(acc[0], acc[1]); w.y = pk2(acc[2], acc[3]); w.z = pk2(acc[4], acc[5]); w.w = pk2(acc[6], acc[7]);
            *(u32x4*)(mo + (size_t)row * D + c) = w; }
    }
    __syncthreads();
}
DI void phase_prep(const Ctx& F, int l) {
    for (int it = F.blk; it < 1024; it += F.G) {
        if (it < 512) mix_prep<true>(F, l, it >> 5, it & 31);
        else mix_prep<false>(F, l, (it - 512) >> 5, it & 31);
    }
    __syncthreads();
}
DI void phase_mixer(const Ctx& F, int l) {
    const int blk = F.blk;
#ifndef PROBE_SEQ
#define PROBE_SEQ 1
#endif
#ifndef PROBE_SMP
#define PROBE_SMP 1
#endif
    if (blk < 32) { for (int rep = 0; rep < PROBE_SEQ; ++rep) mix_seq_prompt<true>(F, l, blk >> 1, blk & 1); }
    else if (blk < 64) { for (int rep = 0; rep < PROBE_SEQ; ++rep) mix_seq_prompt<false>(F, l, (blk - 32) >> 1, blk & 1); }
    else {
        const int nslots = (F.G - 64) * 8;
        for (int ws_ = (blk - 64) * 8 + F.wave; ws_ < 1536; ws_ += nslots) {
            const int g3 = ws_ / 3, r3 = ws_ - 3 * g3;
            if (r3 == 0) mix_sample_wave<true>(F, l, g3, F.lane);
            else mix_sample_wave<false>(F, l, g3 * 2 + (r3 - 1), F.lane);
        }
        for (int it = blk - 64; it < 136; it += F.G - 64) mix_conv(F, l, it);
        __syncthreads();
        phase_convert(F, l, blk - 64, F.G - 64, l == 0 ? (2 | 4 | 8) : (4 | 8));
    }
    __syncthreads();
}

#define XB_TMO      128
#define XB_XCNT(j)  (256  + 64 * (j))
#define XB_XSUB(j)  (1280 + 64 * (j))
#define XB_XGEN(j)  (2304 + 64 * (j))
#define XB_TOP      3328
#define XB_TOPGEN   3392
#define XCD_BAR_WORDS 3456
#define XB_SPIN_CAP (1u << 18)
DI unsigned xb_ld(unsigned* p)              { return __hip_atomic_load(p, __ATOMIC_RELAXED, __HIP_MEMORY_SCOPE_AGENT); }
DI unsigned xb_add(unsigned* p, unsigned v) { return __hip_atomic_fetch_add(p, v, __ATOMIC_RELAXED, __HIP_MEMORY_SCOPE_AGENT); }
DI unsigned xb_xcc_id() { return (unsigned)__builtin_amdgcn_s_getreg((3 << 11) | 20) & 0xFu; }
#define XB_SPIN(cond, bar) do { unsigned _sp = 0; while (cond) { __builtin_amdgcn_s_sleep(1); \
    if ((++_sp & 255u) == 0u) { if (xb_ld(&(bar)[XB_TMO])) break; if (_sp > XB_SPIN_CAP) { atomicAdd(&(bar)[XB_TMO], 1u); break; } } } } while (0)
struct XcdBarrier { unsigned* bar; unsigned x; volatile LAS unsigned* st; };
DI void xcd_barrier_complete(unsigned* bar, unsigned x, unsigned& nloc, unsigned& nx) {
    const unsigned G = gridDim.x * gridDim.y * gridDim.z;
    unsigned sum, cnt, mine, sp = 0u;
    for (;;) {
        sum = 0u; cnt = 0u; mine = 0u;
#pragma unroll
        for (unsigned j = 0; j < 16; ++j) { const unsigned c = xb_ld(&bar[XB_XCNT(j)]); sum += c; cnt += (c > 0u) ? 1u : 0u; mine = (j == x) ? c : mine; }
        if (sum == G) break;
        __builtin_amdgcn_s_sleep(1);
        if ((++sp & 255u) == 0u) { if (xb_ld(&bar[XB_TMO])) break; if (sp > XB_SPIN_CAP) { atomicAdd(&bar[XB_TMO], 1u); break; } }
    }
    nloc = mine > 0u ? mine : 1u; nx = cnt > 0u ? cnt : 1u;
}
DI void xcd_barrier(const XcdBarrier& b) {
    asm volatile("s_waitcnt vmcnt(0)" ::: "memory");
    __syncthreads();
    if (threadIdx.x == 0) {
        unsigned* bar = b.bar;
        __builtin_amdgcn_s_waitcnt(0);
        unsigned nloc = b.st[0], nx = b.st[1];
        if (nloc == 0u) { xcd_barrier_complete(bar, b.x, nloc, nx); b.st[0] = nloc; b.st[1] = nx; }
        const unsigned old = xb_add(&bar[XB_XSUB(b.x)], 1u);
        const unsigned gen = old / nloc;
        if (old + 1u == (gen + 1u) * nloc) {
            __builtin_amdgcn_fence(__ATOMIC_RELEASE, "agent");
            asm volatile("s_waitcnt vmcnt(0)" ::: "memory");
            const unsigned og = xb_add(&bar[XB_TOP], 1u);
            const unsigned tg = og / nx;
            if (og + 1u == (tg + 1u) * nx) xb_add(&bar[XB_TOPGEN], 1u);
            else XB_SPIN(xb_ld(&bar[XB_TOPGEN]) == tg, bar);
            __builtin_amdgcn_fence(__ATOMIC_ACQUIRE, "agent");
            xb_add(&bar[XB_XGEN(b.x)], 1u);
            asm volatile("s_waitcnt vmcnt(0)" ::: "memory");
        } else {
            XB_SPIN(xb_ld(&bar[XB_XGEN(b.x)]) == gen, bar);
            __builtin_amdgcn_fence(__ATOMIC_ACQUIRE, "agent");
            asm volatile("s_waitcnt vmcnt(0)" ::: "memory");
        }
    }
    __syncthreads();
}

DI void run_phase(const Ctx& F, int ph) {
    if (ph == 0) { if (PHON(8)) phase_convert(F, 0, F.blk, F.G, 1 | 16); if (PHON(9)) phase_norm<0>(F, 0, true); return; }
    const int q = ph - 1, l = q / 11, s_ = q - 11 * l;
    const int s = s_ == 0 ? 0 : s_ == 1 ? 8 : s_ == 2 ? 1 : s_ == 3 ? 9 : s_ == 4 ? 2 : s_ == 5 ? 10 : s_ - 3;
    switch (s) {
    case 0: if (PHON(0)) { pg8::Gemm g{F.hb(), F.wt_in(l), D}; pg8::StaticOrder S; S.init(MROWS, NZ, D, F.G, F.blk);
        pg8::EpiBf16<0> E{F.zb(), NZ, 0}; pg8::gemm_phase(F.lds, F.tid, g, S, E); } break;
    case 1: if (PHON(1)) phase_mixer(F, l); break;
    case 2: if (PHON(2)) { pg8::Gemm g{F.ocat(), F.wt_br(l), 3072}; pg8::SegOrder S; S.init(MROWS, D, F.G, F.blk);
        pg8::EpiBf16<0> E{F.pbr(), 3 * D, D}; pg8::gemm_phase(F.lds, F.tid, g, S, E);
        if (l == 0 && F.blk >= 48) phase_convert(F, 1, F.blk - 48, F.G - 48, 1); } break;
    case 3: case 6: if (PHON(3)) {
        const bool dn = (s == 6);
        pg8::Gemm g{dn ? F.zb() : F.mb(), dn ? F.wt_dn(l) : F.wt_o(l), dn ? DFF : D};
        pg8::TailOrder S; S.init(dn ? DFF : D, F.blk, dn ? 3 : 2);
        pg8::EpiRes E{(!dn && l == 0) ? F.in0 : F.xws(), F.xws(), F.part()};
        pg8::gemm_phase(F.lds, F.tid, g, S, E); } break;
    case 4: if (PHON(4)) phase_norm<1>(F, l, false); break;
    case 5: if (PHON(5)) { pg8::Gemm g{F.hb(), F.wt_up(l), D}; pg8::StaticOrder S; S.init(MROWS, DFF, D, F.G, F.blk);
        pg8::EpiBf16<1> E{F.zb(), DFF, 0}; pg8::gemm_phase(F.lds, F.tid, g, S, E);
        if (l == 0 && F.blk >= 64) phase_convert(F, 1, F.blk - 64, F.G - 64, 16 | 2); } break;
    case 8: phase_prep(F, l); break;
    case 9: phase_post(F, l); break;
    case 10: phase_merge(F); break;
    default: if (PHON(7)) { if (l == 0) phase_norm<0>(F, 1, false); else phase_norm<2>(F, 0, false); } break;
    }
}
constexpr int N_PHASES = 23;

__global__ void __launch_bounds__(512, 2) fwd_kernel(Args a) {
    extern __shared__ __attribute__((aligned(16))) unsigned char lds_raw[];
    typedef const __attribute__((address_space(4))) Args* ArgsP;
    volatile LAS unsigned* xb_st = (volatile LAS unsigned*)((LAS unsigned char*)lds_raw + LDS_XB);
    if (a.ph_hi - a.ph_lo > 1) {
        if (threadIdx.x == 0) { xb_st[0] = 0u; xb_st[1] = 0u; }
        __syncthreads();
        if (threadIdx.x == 0) (void)xb_add(&((unsigned*)(a.ws + WS_BAR))[XB_XCNT(xb_xcc_id())], 1u);
    }
    for (int ph = a.ph_lo; ph < a.ph_hi; ++ph) {
        Ctx F;
        {
            ArgsP ap = (ArgsP)__builtin_amdgcn_kernarg_segment_ptr(); asm volatile("" : "+s"(ap));
            F.in0 = ap->in[0]; F.in1 = ap->in[1]; F.in2 = ap->in[2]; F.in3 = ap->in[3]; F.in4 = ap->in[4]; F.in5 = ap->in[5]; F.in6 = ap->in[6]; F.in7 = ap->in[7]; F.in8 = ap->in[8]; F.in9 = ap->in[9]; F.in10 = ap->in[10];
            F.in11 = ap->in[11]; F.in12 = ap->in[12]; F.in13 = ap->in[13]; F.in14 = ap->in[14]; F.in15 = ap->in[15]; F.in16 = ap->in[16]; F.in17 = ap->in[17]; F.in18 = ap->in[18]; F.in19 = ap->in[19]; F.in20 = ap->in[20];
            F.out = ap->out; F.ws = ap->ws; F.lds = (LAS unsigned char*)lds_raw; F.G = gridDim.x; F.blk = blockIdx.x;
            int t_ = threadIdx.x; asm volatile("" : "+v"(t_)); F.tid = t_; F.lane = t_ & 63; F.wave = __builtin_amdgcn_readfirstlane(t_ >> 6);
        }
        run_phase(F, ph);
#ifdef PROBE_DUP
        if ((PROBE_DUP >> (ph == 0 ? 15 : ((ph - 1) % 11))) & 1) { __syncthreads(); cg::this_grid().sync(); run_phase(F, ph); }
#endif
        if (ph + 1 < a.ph_hi) {
            if (a.ph_lo < 0) cg::this_grid().sync();
            { XcdBarrier xb; xb.bar = (unsigned*)(a.ws + WS_BAR); xb.x = xb_xcc_id(); xb.st = xb_st; xcd_barrier(xb); }
        }
    }
}

extern "C" void kernel_launch(void* const* d_in, const int* in_sizes, int n_in, void* d_out, int out_size, void* d_ws, size_t ws_size, hipStream_t stream) {
    static int grid = 0;
    if (grid == 0) {
        if (n_in != 21 || ws_size < WS_END) { fprintf(stderr, "kernel_launch: need 21 inputs and >= %zu bytes of workspace (got %d, %zu)\n", (size_t)WS_END, n_in, ws_size); grid = -1; return; }
        int dev = 0, cus = 0, per_cu = 0;
        hipGetDevice(&dev);
        hipDeviceGetAttribute(&cus, hipDeviceAttributeMultiprocessorCount, dev);
        if (hipFuncSetAttribute((const void*)fwd_kernel, hipFuncAttributeMaxDynamicSharedMemorySize, LDS_BYTES) != hipSuccess) { fprintf(stderr, "kernel_launch: hipFuncSetAttribute failed\n"); grid = -1; return; }
        if (hipOccupancyMaxActiveBlocksPerMultiprocessor(&per_cu, (const void*)fwd_kernel, 512, LDS_BYTES) != hipSuccess || per_cu < 1) { fprintf(stderr, "kernel_launch: occupancy query says %d blocks per CU\n", per_cu); per_cu = 1; }
        (void)hipGetLastError();
        if (cus != 256) { fprintf(stderr, "kernel_launch: built for a 256-CU device (got %d CUs)\n", cus); grid = -1; return; }
        grid = cus;
    }
    if (grid < 0) return;
    Args a{};
    for (int i = 0; i < 21; ++i) a.in[i] = (const float*)d_in[i];
    a.out = (float*)d_out; a.ws = (unsigned char*)d_ws;
#if MK_MULTI
    for (int ph = 0; ph < N_PHASES; ++ph) { a.ph_lo = ph; a.ph_hi = ph + 1;
        hipLaunchKernelGGL(fwd_kernel, dim3(grid), dim3(512), LDS_BYTES, stream, a); }
#else
    a.ph_lo = 0; a.ph_hi = N_PHASES;
    if (hipMemsetAsync((unsigned char*)d_ws + WS_BAR, 0, 16384, stream) != hipSuccess) { fprintf(stderr, "kernel_launch: hipMemsetAsync of the barrier words failed\n"); return; }
    void* args[] = {&a};
    hipError_t e = hipLaunchCooperativeKernel((const void*)fwd_kernel, dim3(grid), dim3(512), args, LDS_BYTES, stream);
    if (e != hipSuccess) fprintf(stderr, "kernel_launch: cooperative launch failed: %s (grid %d)\n", hipGetErrorString(e), grid);
#endif
}
```

```cpp
#include <hip/hip_runtime.h>
#include <hip/hip_cooperative_groups.h>
#include <cstdio>
namespace cg = cooperative_groups;

#ifndef MK_MULTI
#define MK_MULTI 0
#endif

#ifndef PHMASK
#define PHMASK 0xffff
#endif
#define PHON(b) ((PHMASK >> (b)) & 1)
#define LAS __attribute__((address_space(3)))
#define DI __device__ __forceinline__
typedef unsigned short bf16_t;
typedef short bf16x8 __attribute__((ext_vector_type(8)));
typedef short s16x4 __attribute__((ext_vector_type(4)));
typedef float f32x2 __attribute__((ext_vector_type(2)));
typedef float f32x4 __attribute__((ext_vector_type(4)));
typedef float f32x16 __attribute__((ext_vector_type(16)));
typedef unsigned u32x4 __attribute__((ext_vector_type(4)));
typedef unsigned u32x2 __attribute__((ext_vector_type(2)));
typedef __bf16 bf16x2_t __attribute__((ext_vector_type(2)));

constexpr int D = 2048, MP = 8192, MS = 512, MROWS = 8704, TP = 2048;
constexpr int INC = 15376;
constexpr int NZ = 15360;
constexpr int ZQA = 0, ZKA = 512, ZVA = 1024, ZRA = 2048, ZQR = 3072, ZKR = 3584, ZVR = 4096, ZGR = 5120, ZCB = 6144, ZCC = 7168, ZCH = 8192, ZGATE = 9216;
constexpr int DFF = 8192;
constexpr int LDS_XB = 149504;
constexpr int LDS_BYTES = LDS_XB + 16;
constexpr size_t O_YP = 0, O_YS = 16777216, O_GLAP = 17825792, O_RETP = 18874368, O_CONVP = 19398656, O_GLAS = 19415040, O_RETS = 52969472, O_CONVS = 69746688;
constexpr size_t SZ_WIN = (size_t)NZ * D * 2, SZ_WBR = (size_t)D * 3072 * 2, SZ_WO = (size_t)D * D * 2, SZ_WUP = (size_t)DFF * D * 2, SZ_WDN = (size_t)D * DFF * 2;
constexpr size_t WS_WIN = 0, WS_WBR = WS_WIN + 2 * SZ_WIN, WS_WO = WS_WBR + 2 * SZ_WBR, WS_WUP = WS_WO + 2 * SZ_WO, WS_WDN = WS_WUP + 2 * SZ_WUP;
constexpr size_t WS_X = WS_WDN + 2 * SZ_WDN;
constexpr size_t WS_H = WS_X + (size_t)MROWS * D * 4;
constexpr size_t WS_Z = WS_H + (size_t)MROWS * D * 2;
constexpr size_t WS_ALR = WS_Z + (size_t)MROWS * NZ * 2;
constexpr size_t WS_OCAT = WS_ALR + (size_t)MROWS * 16 * 4;
constexpr size_t WS_M = WS_OCAT + (size_t)MROWS * 3072 * 2;
constexpr size_t WS_MT = WS_M + (size_t)MROWS * D * 2;
constexpr size_t WS_IMG = WS_MT + (size_t)MROWS * D * 4;
constexpr size_t WS_BAR = WS_IMG + (size_t)1024 * 93184;
constexpr size_t WS_END = WS_BAR + 16384;

__device__ const double INVF_REV[32] = {0.15915494309189535, 0.11934937021124886, 0.08949940160889101, 0.06711508300522726, 0.050329212104487035, 0.03774158471741977, 0.0283021958306234, 0.02122365276477766, 0.015915494309189534, 0.011934937021124886, 0.008949940160889102, 0.006711508300522725, 0.005032921210448704, 0.003774158471741977, 0.00283021958306234, 0.0021223652764777662, 0.0015915494309189536, 0.0011934937021124885, 0.0008949940160889102, 0.0006711508300522726, 0.0005032921210448703, 0.00037741584717419774, 0.00028302195830623395, 0.0002122365276477766, 0.00015915494309189535, 0.00011934937021124886, 8.949940160889102e-05, 6.711508300522725e-05, 5.0329212104487035e-05, 3.774158471741978e-05, 2.8302195830623396e-05, 2.122365276477766e-05};
struct Args { const float* in[21]; float* out; unsigned char* ws; int ph_lo, ph_hi; };

DI unsigned pk2(float a, float b) { f32x2 v = {a, b}; bf16x2_t r = __builtin_convertvector(v, bf16x2_t); return __builtin_bit_cast(unsigned, r); }
DI bf16_t f2bf(float a) { return (bf16_t)(pk2(a, 0.f) & 0xffffu); }
DI float bf2f(bf16_t b) { return __uint_as_float(((unsigned)b) << 16); }
DI float bflo(unsigned w) { return __uint_as_float(w << 16); }
DI float bfhi(unsigned w) { return __uint_as_float(w & 0xffff0000u); }
DI float sigmoidf_(float x) { return __builtin_amdgcn_rcpf(1.0f + __expf(-x)); }
DI float siluf_(float x) { return x * sigmoidf_(x); }
DI float logsigmoidf_(float x) { return fminf(x, 0.f) - log1pf(__expf(-fabsf(x))); }
DI int crow(int reg, int h) { return (reg & 3) + 8 * (reg >> 2) + 4 * h; }
DI bf16x8 pack_step(const f32x16& x, int s) {
    u32x4 p;
    p[0] = pk2(x[8 * s + 0], x[8 * s + 1]); p[1] = pk2(x[8 * s + 2], x[8 * s + 3]);
    p[2] = pk2(x[8 * s + 4], x[8 * s + 5]); p[3] = pk2(x[8 * s + 6], x[8 * s + 7]);
    return __builtin_bit_cast(bf16x8, p);
}
DI bf16x8 cat4(s16x4 lo, s16x4 hi) { return __builtin_shufflevector(lo, hi, 0, 1, 2, 3, 4, 5, 6, 7); }
#define MFMA32(a, b, c) __builtin_amdgcn_mfma_f32_32x32x16_bf16((a), (b), (c), 0, 0, 0)

namespace pg8 {
constexpr int BM = 256, BK = 64, HALF = 128, HTB = HALF * BK * 2, NXCD = 8, WGM = 8;
DI int lds_byte(int r, int c) { const int st = (r >> 4) * 2 + (c >> 5), rr = r & 15, cc = c & 31, ob = rr * 64 + cc * 2; return st * 1024 + (ob ^ (((ob >> 9) & 1) << 5)); }
DI void stage_rc(int b, int& R, int& C) { const int st = b / 1024, sb = b % 1024, swz = sb ^ (((sb >> 9) & 1) << 5); R = (st >> 1) * 16 + swz / 64; C = (st & 1) * 32 + (swz % 64) / 2; }
DI int perm32(int rho) { const int n = rho >> 4, i = rho & 15; return 8 * (i >> 2) + 4 * n + (i & 3); }

struct Unit { int pm, pn, kt0, nt; };
struct Gemm { const bf16_t* A; const bf16_t* Bt; int ld; };

DI void map_tile(int wgid, int nM, int nN, int& pm, int& pn) {
    const int nwg = nM * nN;
    { const int q = nwg / NXCD, r = nwg % NXCD, xcd = wgid % NXCD, off = wgid / NXCD; wgid = (xcd < r ? xcd * (q + 1) : r * (q + 1) + (xcd - r) * q) + off; }
    const int nig = WGM * nN, gid = wgid / nig, fm = gid * WGM, gsz = (nM - fm) < WGM ? (nM - fm) : WGM;
    pm = fm + ((wgid % nig) % gsz); pn = (wgid % nig) / gsz;
}
struct StaticOrder {
    int nM, nN, nwg, G, c, nt;
    DI void init(int M, int N, int K, int G_, int c_) { nM = M / BM; nN = N / BM; nwg = nM * nN; G = G_; c = c_; nt = K / BK; }
    DI bool next(int i, Unit& u) const {
        const long L = (long)i * G + c; if (L >= nwg) return false;
        map_tile((int)L, nM, nN, u.pm, u.pn); u.kt0 = 0; u.nt = nt; return true;
    }
};
struct SegOrder {
    int nM, nN, nwg, G, c;
    DI void init(int M, int N, int G_, int c_) { nM = M / BM; nN = N / BM; nwg = nM * nN; G = G_; c = c_; }
    DI bool next(int i, Unit& u) const {
        const long L = (long)i * G + c; if (L >= 3 * nwg) return false;
        const int br = (int)(L / nwg), t = (int)(L - (long)br * nwg);
        map_tile(t, nM, nN, u.pm, u.pn); u.kt0 = br * 16; u.nt = 16; return true;
    }
};
struct TailOrder {
    int c, nt, ls;
    DI void init(int K, int c_, int ls_) { c = c_; nt = K / BK; ls = ls_; }
    DI bool next(int i, Unit& u) const {
        if (i == 0) { map_tile(c, 32, 8, u.pm, u.pn); u.kt0 = 0; u.nt = nt; return true; }
        if (i == 1 && c < (16 << ls)) { const int ts = c >> ls, piece = c & ((1 << ls) - 1); u.pm = 32 + (ts >> 3); u.pn = ts & 7; u.nt = nt >> ls; u.kt0 = piece * u.nt; return true; }
        return false;
    }
};

template <int ACT> struct EpiBf16 {
    static constexpr bool PERM = true;
    bf16_t* O; int ldc; int segN;
    DI void operator()(const f32x4 (&acc)[2][2][4][2], const Unit& u, int wr, int wc, int fr, int fq) const {
        const int row0 = u.pm * BM + wr * 64 + fr, col0 = u.pn * BM + (u.kt0 >> 4) * segN + wc * 32 + 8 * fq;
#pragma unroll
        for (int ai = 0; ai < 2; ++ai)
#pragma unroll
            for (int m = 0; m < 4; ++m) { bf16_t* rowp = O + (size_t)(row0 + ai * HALF + m * 16) * ldc + col0;
#pragma unroll
                for (int bj = 0; bj < 2; ++bj) { f32x4 v0 = acc[ai][bj][m][0], v1 = acc[ai][bj][m][1];
                    if (ACT == 1) {
#pragma unroll
                        for (int j = 0; j < 4; ++j) { const float a = fmaxf(v0[j], 0.f), b = fmaxf(v1[j], 0.f); v0[j] = a * a; v1[j] = b * b; } }
                    u32x4 w; w.x = pk2(v0[0], v0[1]); w.y = pk2(v0[2], v0[3]); w.z = pk2(v1[0], v1[1]); w.w = pk2(v1[2], v1[3]);
                    *(u32x4*)(rowp + bj * HALF) = w; } }
    }
};
struct EpiRes {
    static constexpr bool PERM = false;
    const float* bp; float* out; float* part;
    DI void operator()(const f32x4 (&acc)[2][2][4][2], const Unit& u, int wr, int wc, int fr, int fq) const {
        const bool tail = u.pm >= 32;
        const size_t off0 = (size_t)((tail ? (u.kt0 / u.nt) * MS - MP : 0) + u.pm * BM + wr * 64 + fr) * D + u.pn * BM + wc * 32 + 4 * fq;
#pragma unroll
        for (int ai = 0; ai < 2; ++ai)
#pragma unroll
            for (int m = 0; m < 4; ++m) { const size_t off = off0 + (size_t)(ai * HALF + m * 16) * D;
                float* o = out + off + (tail ? (size_t)((WS_IMG - WS_X) / 4) : (size_t)0);
                if (tail) {
#pragma unroll
                    for (int bj = 0; bj < 2; ++bj)
#pragma unroll
                        for (int n = 0; n < 2; ++n) { float* p = o + bj * HALF + n * 16;
                            *(f32x4*)p = acc[ai][bj][m][n]; }
                } else {
                    const float* b = bp + off;
#pragma unroll
                    for (int bj = 0; bj < 2; ++bj)
#pragma unroll
                        for (int n = 0; n < 2; ++n) { const int c = bj * HALF + n * 16; *(f32x4*)(o + c) = *(const f32x4*)(b + c) + acc[ai][bj][m][n]; }
                }
                asm volatile("" ::: "memory"); }
    }
};
template <class Epi, class Sched>
DI void gemm_phase(LAS unsigned char* lds, const int tid, const Gemm g, const Sched& S, const Epi& E) {
    const int wid = __builtin_amdgcn_readfirstlane(tid >> 6), lane = tid & 63, wr = wid >> 2, wc = wid & 3, fr = lane & 15, fq = lane >> 4;
    const int K = g.ld;
    unsigned voffA[2], voffB[2];
#pragma unroll
    for (int i = 0; i < 2; ++i) { int R, C; stage_rc(tid * 16 + i * 8192, R, C); const int Rb = Epi::PERM ? ((R & ~31) + perm32(R & 31)) : R;
        voffA[i] = (unsigned)(R * K + C) * 2u; voffB[i] = (unsigned)(Rb * K + C) * 2u; }
    const size_t kstep = (size_t)(BK * 2);
    const size_t hstep = (size_t)HALF * K * 2;
    const size_t tstep = 2 * hstep;
    const unsigned ldsw = (unsigned)wid * 1024u;
    const int aoff = lds_byte(wr * 64 + fr, fq * 8), boff = lds_byte(wc * 32 + fr, fq * 8);
#define PG8_SA(b, h) (((b) * 2 + (h)) * HTB)
#define PG8_SB(b, h) ((4 + (b) * 2 + (h)) * HTB)
#define PG8_STAGE(bufoff, gbase, voff) do { _Pragma("unroll") for (int _i = 0; _i < 2; ++_i) \
        __builtin_amdgcn_global_load_lds((const unsigned*)((const char*)(gbase) + (voff)[_i]), (LAS unsigned*)(lds + (bufoff) + ldsw + _i * 8192), 16, 0, 0); } while (0)
#define PG8_LDA(dst, b, h) do { _Pragma("unroll") for (int m = 0; m < 4; ++m) _Pragma("unroll") for (int k = 0; k < 2; ++k) dst[m][k] = *(const LAS bf16x8*)(lds + PG8_SA(b, h) + aoff + m * 2048 + k * 1024); } while (0)
#define PG8_LDB(dst, b, h) do { _Pragma("unroll") for (int n = 0; n < 2; ++n) _Pragma("unroll") for (int k = 0; k < 2; ++k) dst[n][k] = *(const LAS bf16x8*)(lds + PG8_SB(b, h) + boff + n * 2048 + k * 1024); } while (0)
#define PG8_MMA(ai, bj, At, Bt) do { __builtin_amdgcn_s_setprio(1); _Pragma("unroll") for (int m = 0; m < 4; ++m) _Pragma("unroll") for (int n = 0; n < 2; ++n) _Pragma("unroll") for (int k = 0; k < 2; ++k) \
        acc[ai][bj][m][n] = __builtin_amdgcn_mfma_f32_16x16x32_bf16(Bt[n][k], At[m][k], acc[ai][bj][m][n], 0, 0, 0); __builtin_amdgcn_s_setprio(0); } while (0)
#define PG8_WAIT_V(n) asm volatile("s_waitcnt vmcnt(" #n ")" ::: "memory")
#define PG8_WAIT_L(n) asm volatile("s_waitcnt lgkmcnt(" #n ")" ::: "memory")
#define PG8_BAR __builtin_amdgcn_s_barrier()
#define PG8_SCHED __builtin_amdgcn_sched_barrier(0)
    Unit cur, nxt; int ui = 0;
    if (!S.next(0, cur)) return;
    f32x4 acc[2][2][4][2];
#pragma unroll
    for (int a = 0; a < 2; ++a)
#pragma unroll
        for (int b = 0; b < 2; ++b)
#pragma unroll
            for (int m = 0; m < 4; ++m)
#pragma unroll
                for (int n = 0; n < 2; ++n) acc[a][b][m][n] = (f32x4){0.f, 0.f, 0.f, 0.f};
    bf16x8 At[4][2], B0[2][2], B1[2][2];
    const char* cA = (const char*)g.A + (size_t)cur.pm * tstep + (size_t)cur.kt0 * kstep;
    const char* cB = (const char*)g.Bt + (size_t)cur.pn * tstep + (size_t)cur.kt0 * kstep;
    PG8_STAGE(PG8_SB(0, 0), cB, voffB); PG8_STAGE(PG8_SB(0, 1), cB + hstep, voffB); PG8_STAGE(PG8_SA(0, 0), cA, voffA); PG8_STAGE(PG8_SA(0, 1), cA + hstep, voffA);
    if (wr == 1) PG8_BAR;
    PG8_WAIT_V(2); PG8_BAR;
    PG8_STAGE(PG8_SB(1, 0), cB + kstep, voffB); PG8_STAGE(PG8_SA(1, 0), cA + kstep, voffA); PG8_STAGE(PG8_SB(1, 1), cB + hstep + kstep, voffB);
    PG8_WAIT_V(6); PG8_BAR;
    for (;;) {
        const bool has_next = S.next(ui + 1, nxt);
        const char* nA = has_next ? (const char*)g.A + (size_t)nxt.pm * tstep + (size_t)nxt.kt0 * kstep : cA;
        const char* nB = has_next ? (const char*)g.Bt + (size_t)nxt.pn * tstep + (size_t)nxt.kt0 * kstep : cB;
        const int nt = cur.nt;
        for (int t = 0; t < nt; t += 2) {
            const bool last = (t == nt - 2);
            const char* a1 = cA + (size_t)(t + 1) * kstep;
            const char* a2 = last ? nA : cA + (size_t)(t + 2) * kstep; const char* b2 = last ? nB : cB + (size_t)(t + 2) * kstep;
            const char* a3 = a2 + kstep; const char* b3 = b2 + kstep;
            PG8_LDB(B0, 0, 0); PG8_LDB(B1, 0, 1); PG8_SCHED; PG8_LDA(At, 0, 0); PG8_STAGE(PG8_SA(1, 1), a1 + hstep, voffA);
            PG8_WAIT_V(8); PG8_WAIT_L(0); PG8_BAR; PG8_MMA(0, 0, At, B0); PG8_MMA(0, 1, At, B1); PG8_BAR; PG8_SCHED;
            PG8_LDA(At, 0, 1); PG8_STAGE(PG8_SB(0, 0), b2, voffB); PG8_STAGE(PG8_SB(0, 1), b2 + hstep, voffB); PG8_STAGE(PG8_SA(0, 0), a2, voffA);
            PG8_WAIT_V(8); PG8_WAIT_L(0); PG8_BAR; PG8_MMA(1, 0, At, B0); PG8_MMA(1, 1, At, B1); PG8_BAR; PG8_SCHED;
            PG8_LDB(B0, 1, 0); PG8_LDB(B1, 1, 1); PG8_SCHED; PG8_LDA(At, 1, 0); PG8_STAGE(PG8_SA(0, 1), a2 + hstep, voffA);
            PG8_WAIT_V(8); PG8_WAIT_L(0); PG8_BAR; PG8_MMA(0, 0, At, B0); PG8_MMA(0, 1, At, B1); PG8_BAR; PG8_SCHED;
            PG8_LDA(At, 1, 1); PG8_STAGE(PG8_SB(1, 0), b3, voffB); PG8_STAGE(PG8_SB(1, 1), b3 + hstep, voffB); PG8_STAGE(PG8_SA(1, 0), a3, voffA);
            PG8_WAIT_V(8); PG8_WAIT_L(0); PG8_BAR; PG8_MMA(1, 0, At, B0); PG8_MMA(1, 1, At, B1); PG8_BAR; PG8_SCHED;
        }
        if (wr == 0) PG8_BAR;
        E(acc, cur, wr, wc, fr, fq);
        if (!has_next) break;
#pragma unroll
        for (int a = 0; a < 2; ++a)
#pragma unroll
            for (int b = 0; b < 2; ++b)
#pragma unroll
                for (int m = 0; m < 4; ++m)
#pragma unroll
                    for (int n = 0; n < 2; ++n) acc[a][b][m][n] = (f32x4){0.f, 0.f, 0.f, 0.f};
        cur = nxt; cA = nA; cB = nB; ++ui;
        if (wr == 1) PG8_BAR;
    }
    PG8_WAIT_V(0);
    PG8_BAR;
#undef PG8_SA
#undef PG8_SB
#undef PG8_STAGE
#undef PG8_LDA
#undef PG8_LDB
#undef PG8_MMA
#undef PG8_WAIT_V
#undef PG8_WAIT_L
#undef PG8_BAR
#undef PG8_SCHED
}
}

struct Ctx {
    const float *in0, *in1, *in2, *in3, *in4, *in5, *in6, *in7, *in8, *in9, *in10, *in11, *in12, *in13, *in14, *in15, *in16, *in17, *in18, *in19, *in20; float* out; unsigned char* ws; LAS unsigned char* lds; int tid, lane, wave, G, blk;
    DI bf16_t* wt_in(int l) const { return (bf16_t*)(ws + WS_WIN + (size_t)l * SZ_WIN); }
    DI bf16_t* wt_br(int l) const { return (bf16_t*)(ws + WS_WBR + (size_t)l * SZ_WBR); }
    DI bf16_t* wt_o(int l) const { return (bf16_t*)(ws + WS_WO + (size_t)l * SZ_WO); }
    DI bf16_t* wt_up(int l) const { return (bf16_t*)(ws + WS_WUP + (size_t)l * SZ_WUP); }
    DI bf16_t* wt_dn(int l) const { return (bf16_t*)(ws + WS_WDN + (size_t)l * SZ_WDN); }
    DI float* xws() const { return (float*)(ws + WS_X); }
    DI bf16_t* hb() const { return (bf16_t*)(ws + WS_H); }
    DI bf16_t* zb() const { return (bf16_t*)(ws + WS_Z); }
    DI float* alr() const { return (float*)(ws + WS_ALR); }
    DI bf16_t* ocat() const { return (bf16_t*)(ws + WS_OCAT); }
    DI bf16_t* mb() const { return (bf16_t*)(ws + WS_M); }
    DI bf16_t* pbr() const { return (bf16_t*)(ws + WS_MT); }
    DI float* part() const { return (float*)(ws + WS_IMG); }
};

DI void convert_tile(const Ctx& F, const float* src, int ldsrc, int n0src, bf16_t* dst, int ldd, int n0, int k0) {
    LAS bf16_t* T = (LAS bf16_t*)F.lds;
    constexpr int LT = 264;
    const int tid = F.tid;
    const int n4 = tid & 15, kr = tid >> 4;
    f32x4 v[8];
#pragma unroll
    for (int p = 0; p < 8; ++p) v[p] = *(const f32x4*)(src + (size_t)(k0 + kr + 32 * p) * ldsrc + n0src + n4 * 4);
#pragma unroll
    for (int p = 0; p < 8; ++p) { const int k = kr + 32 * p;
#pragma unroll
        for (int e = 0; e < 4; ++e) T[(n4 * 4 + e) * LT + k] = f2bf(v[p][e]); }
    __syncthreads();
    const int kc = tid & 31, nr = tid >> 5;
#pragma unroll
    for (int p = 0; p < 4; ++p) { const int n = nr + 16 * p;
        const u32x4 w = *(const LAS u32x4*)(T + n * LT + kc * 8);
        *(u32x4*)(dst + (size_t)(n0 + n) * ldd + k0 + kc * 8) = w; }
    __syncthreads();
}
DI void phase_convert(const Ctx& F, const int l, const int wg, const int nwg, const int jobs) {
    int base = 0;
#define CV_JOB(count, ...) do { for (int t = (((wg - base) % nwg) + nwg) % nwg; t < (count); t += nwg) { __VA_ARGS__; } base += (count); } while (0)
    if (jobs & 1) CV_JOB(960, { const int nt_ = t % 240, kt_ = t / 240; const int n0 = nt_ * 64; const int n0s = n0 + (n0 >= 2048 ? 16 : 0);
        convert_tile(F, F.in6 + (size_t)l * D * INC, INC, n0s, F.wt_in(l), D, n0, kt_ * 256); });
    if (jobs & 16) CV_JOB(960, { const int t2 = t + 960; const int nt_ = t2 % 240, kt_ = t2 / 240; const int n0 = nt_ * 64; const int n0s = n0 + (n0 >= 2048 ? 16 : 0);
        convert_tile(F, F.in6 + (size_t)l * D * INC, INC, n0s, F.wt_in(l), D, n0, kt_ * 256); });
    if (jobs & 2) { CV_JOB(128, { const int nt_ = t % 32, kt_ = t / 32; convert_tile(F, F.in13 + (size_t)l * 1024 * D, D, nt_ * 64, F.wt_br(l), 3072, nt_ * 64, kt_ * 256); });
    CV_JOB(128, { const int nt_ = t % 32, kt_ = t / 32; convert_tile(F, F.in14 + (size_t)l * 1024 * D, D, nt_ * 64, F.wt_br(l) + 1024, 3072, nt_ * 64, kt_ * 256); });
    CV_JOB(128, { const int nt_ = t % 32, kt_ = t / 32; convert_tile(F, F.in15 + (size_t)l * 1024 * D, D, nt_ * 64, F.wt_br(l) + 2048, 3072, nt_ * 64, kt_ * 256); });
    CV_JOB(256, { const int nt_ = t % 32, kt_ = t / 32; convert_tile(F, F.in16 + (size_t)l * D * D, D, nt_ * 64, F.wt_o(l), D, nt_ * 64, kt_ * 256); }); }
    if (jobs & 4) { CV_JOB(1024, { const int nt_ = t % 128, kt_ = t / 128; convert_tile(F, F.in18 + (size_t)l * D * DFF, DFF, nt_ * 64, F.wt_up(l), D, nt_ * 64, kt_ * 256); }); }
    if (jobs & 8) { CV_JOB(1024, { const int nt_ = t % 32, kt_ = t / 32; convert_tile(F, F.in19 + (size_t)l * DFF * D, D, nt_ * 64, F.wt_dn(l), DFF, nt_ * 64, kt_ * 256); }); }
#undef CV_JOB
}

DI float wave_sum(float v) {
#pragma unroll
    for (int o = 32; o >= 1; o >>= 1) v += __shfl_xor(v, o);
    return v;
}
template <int MODE>
DI void norm_row(const Ctx& F, int row, bool from_input, const f32x4 (&gv)[8], f32x4 (&xv)[8], int lane) {
    const float* xr = from_input ? ((row < MP) ? F.in0 + (size_t)row * D : F.in1 + (size_t)(row - MP) * D) : F.xws() + (size_t)row * D;
#pragma unroll
    for (int i = 0; i < 8; ++i) xv[i] = *(const f32x4*)(xr + i * 256 + lane * 4);
    if (!from_input && row >= MP) {
#pragma unroll 1
        for (int p = 0; p < (MODE == 1 ? 4 : 8); ++p) { const float* pr = F.part() + ((size_t)p * MS + (row - MP)) * D;
#pragma unroll
            for (int i = 0; i < 8; ++i) xv[i] += *(const f32x4*)(pr + i * 256 + lane * 4); }
        float* xo = F.xws() + (size_t)row * D;
#pragma unroll
        for (int i = 0; i < 8; ++i) *(f32x4*)(xo + i * 256 + lane * 4) = xv[i];
    }
    if (MODE == 0 && from_input && row >= MP) {
        float* xo = F.xws() + (size_t)row * D;
#pragma unroll
        for (int i = 0; i < 8; ++i) *(f32x4*)(xo + i * 256 + lane * 4) = xv[i];
    }
    float ss = 0.f;
#pragma unroll
    for (int i = 0; i < 8; ++i) ss += xv[i][0] * xv[i][0] + xv[i][1] * xv[i][1] + xv[i][2] * xv[i][2] + xv[i][3] * xv[i][3];
    ss = wave_sum(ss);
    const float rstd = rsqrtf(ss * (1.0f / 2048.0f) + 1e-6f);
#pragma unroll
    for (int i = 0; i < 8; ++i) xv[i] = xv[i] * rstd * gv[i];
    if (MODE == 2) {
        float* o = F.out + O_YP + (size_t)row * D;
#pragma unroll
        for (int i = 0; i < 8; ++i) *(f32x4*)(o + i * 256 + lane * 4) = xv[i];
    } else {
        bf16_t* o = F.hb() + (size_t)row * D;
#pragma unroll
        for (int i = 0; i < 8; ++i) { u32x2 w; w.x = pk2(xv[i][0], xv[i][1]); w.y = pk2(xv[i][2], xv[i][3]); *(u32x2*)(o + i * 256 + lane * 4) = w; }
    }
}
template <int MODE>
DI void phase_norm(const Ctx& F, int l, bool from_input) {
    const int tid = F.tid, lane = F.lane, wave = F.wave;
    LAS float* WL = (LAS float*)F.lds;
    if (MODE == 0) {
        const float* w = F.in6 + (size_t)l * D * INC + 2048;
        for (int idx = tid; idx < 2048 * 4; idx += 512) { const int k = idx >> 2, j4 = idx & 3;
            const f32x4 v = *(const f32x4*)(w + (size_t)k * INC + j4 * 4);
            WL[(j4 * 4 + 0) * 2048 + k] = v[0]; WL[(j4 * 4 + 1) * 2048 + k] = v[1]; WL[(j4 * 4 + 2) * 2048 + k] = v[2]; WL[(j4 * 4 + 3) * 2048 + k] = v[3]; }
        __syncthreads();
    }
    const float* gain = (MODE == 0) ? F.in5 + l * D : (MODE == 1) ? F.in17 + l * D : F.in20;
    f32x4 gv[8];
#pragma unroll
    for (int i = 0; i < 8; ++i) gv[i] = *(const f32x4*)(gain + i * 256 + lane * 4);
    const int wslot = F.blk * 8 + wave;
    if (MODE != 0) {
        for (int it = 0; it < 5; ++it) {
            int row = it * 2048 + wslot;
            if (it == 4) { if (wslot & 3) break; row = MP + (wslot >> 2); }
            f32x4 xv[8];
            norm_row<MODE>(F, row, from_input, gv, xv, lane);
        }
    } else {
        for (int pr = 0; pr < 3; ++pr) {
            int row0 = 2 * pr * 2048 + wslot, row1 = row0 + 2048; bool two = true;
            if (pr == 2) { if (wslot & 3) break; row0 = MP + (wslot >> 2); row1 = row0; two = false; }
            f32x4 xa[8], xb[8];
            norm_row<MODE>(F, row0, from_input, gv, xa, lane);
            if (two) norm_row<MODE>(F, row1, from_input, gv, xb, lane);
            else {
#pragma unroll
                for (int i = 0; i < 8; ++i) xb[i] = xa[i];
            }
            float r0 = 0.f, r1 = 0.f;
#pragma unroll 1
            for (int j0 = 0; j0 < 16; j0 += 2) {
                float sv[4];
#pragma unroll
                for (int jj = 0; jj < 2; ++jj) { float s0 = 0.f, s1 = 0.f;
#pragma unroll
                    for (int i = 0; i < 8; ++i) { const f32x4 w = *(const LAS f32x4*)(WL + (j0 + jj) * 2048 + i * 256 + lane * 4);
                        s0 += xa[i][0] * w[0] + xa[i][1] * w[1] + xa[i][2] * w[2] + xa[i][3] * w[3];
                        s1 += xb[i][0] * w[0] + xb[i][1] * w[1] + xb[i][2] * w[2] + xb[i][3] * w[3]; }
                    sv[2 * jj] = s0; sv[2 * jj + 1] = s1; }
#pragma unroll
                for (int o = 32; o >= 1; o >>= 1) {
                    float t[4];
#pragma unroll
                    for (int e = 0; e < 4; ++e) t[e] = __shfl_xor(sv[e], o);
#pragma unroll
                    for (int e = 0; e < 4; ++e) sv[e] += t[e];
                }
#pragma unroll
                for (int jj = 0; jj < 2; ++jj) { r0 = (lane == j0 + jj) ? sv[2 * jj] : r0; r1 = (lane == j0 + jj) ? sv[2 * jj + 1] : r1; }
            }
            if (lane < 16) { F.alr()[(size_t)row0 * 16 + lane] = r0; if (two) F.alr()[(size_t)row1 * 16 + lane] = r1; }
        }
    }
    __syncthreads();
}

constexpr int MX_QT = 0, MX_KT = 18432, MX_KTT = 36864, MX_VT = 55296, MX_EBL = 92160, MX_LDT = 72;
constexpr int IMG_BYTES = 93184;
constexpr int MX_PS = 93184, MX_AL = 95232, MX_W2 = 99328;
constexpr int MX_OSB = 93184, MX_LDOB = 264;

template <bool GLA>
DI void mix_prep(const Ctx& F, int l, int item, int c) {
    constexpr int DK = GLA ? 128 : 64;
    constexpr int LDQ = DK + 8, LDT = MX_LDT;
    constexpr int QOFF = GLA ? ZQA : ZQR, KOFF = GLA ? ZKA : ZKR, VOFF = GLA ? ZVA : ZVR;
    int tid_ = F.tid; asm volatile("" : "+v"(tid_));
    const int tid = tid_;
    LAS bf16_t* QT = (LAS bf16_t*)(F.lds + MX_QT);
    LAS bf16_t* KT = (LAS bf16_t*)(F.lds + MX_KT);
    LAS bf16_t* KTT = (LAS bf16_t*)(F.lds + MX_KTT);
    LAS bf16_t* VT = (LAS bf16_t*)(F.lds + MX_VT);
    LAS float* EBL = (LAS float*)(F.lds + MX_EBL);
    LAS float* PS = (LAS float*)(F.lds + MX_PS);
    LAS float* AL = (LAS float*)(F.lds + MX_AL);
    LAS float* W2L = (LAS float*)(F.lds + MX_W2);
    const bf16_t* z = F.zb();
    const int b = item >> 2;
    const int hh0 = GLA ? (item & 3) : ((2 * item) & 7);
    const int col = tid & 127, part = __builtin_amdgcn_readfirstlane(tid >> 7);
    const int psq = GLA ? 0 : (col >> 6), pkk = GLA ? col : (col & 63);
    const int phh = hh0 + psq;
    const int rowbase = b * TP + c * 64;
    if (GLA) {
#pragma unroll
        for (int jj = 0; jj < 4; ++jj) W2L[(part * 4 + jj) * 128 + col] = F.in7[(size_t)l * 16 * 512 + (part * 4 + jj) * 512 + phh * 128 + pkk];
        if (tid < 256) ((LAS f32x4*)AL)[tid] = ((const f32x4*)(F.alr() + (size_t)rowbase * 16))[tid];
    }
    {
        const int trow = tid & 15, vc = tid >> 4;
        const int zc = VOFF + (GLA ? hh0 * 256 : hh0 * 128) + vc * 8;
        u32x4 w[4];
#pragma unroll
        for (int p = 0; p < 4; ++p) w[p] = *(const u32x4*)(z + (size_t)(rowbase + trow + 16 * p) * NZ + zc);
#pragma unroll
        for (int p = 0; p < 4; ++p) { const int s = trow + 16 * p; LAS bf16_t* d = VT + (vc * 8) * LDT + s;
            d[0 * LDT] = (bf16_t)(w[p].x & 0xffffu); d[1 * LDT] = (bf16_t)(w[p].x >> 16); d[2 * LDT] = (bf16_t)(w[p].y & 0xffffu); d[3 * LDT] = (bf16_t)(w[p].y >> 16);
            d[4 * LDT] = (bf16_t)(w[p].z & 0xffffu); d[5 * LDT] = (bf16_t)(w[p].z >> 16); d[6 * LDT] = (bf16_t)(w[p].w & 0xffffu); d[7 * LDT] = (bf16_t)(w[p].w >> 16); }
    }
    float qr[16], kr[16];
    {
        const int i32 = pkk & 31;
#pragma unroll
        for (int tt = 0; tt < 16; ++tt) { const size_t zr = (size_t)(rowbase + part * 16 + tt) * NZ;
            if (GLA) { qr[tt] = bf2f(z[zr + QOFF + phh * 128 + pkk]); kr[tt] = bf2f(z[zr + KOFF + phh * 128 + pkk]); }
            else {
                const float q1 = bf2f(z[zr + QOFF + phh * 64 + i32]), q2 = bf2f(z[zr + QOFF + phh * 64 + 32 + i32]);
                const float k1 = bf2f(z[zr + KOFF + phh * 64 + i32]), k2 = bf2f(z[zr + KOFF + phh * 64 + 32 + i32]);
                double rev = (double)(c * 64 + part * 16 + tt) * INVF_REV[i32]; rev -= rint(rev);
                const float sn = __builtin_amdgcn_sinf((float)rev), cs = __builtin_amdgcn_cosf((float)rev);
                if (pkk < 32) { qr[tt] = q1 * cs - q2 * sn; kr[tt] = k1 * cs - k2 * sn; } else { qr[tt] = q1 * sn + q2 * cs; kr[tt] = k1 * sn + k2 * cs; }
            } }
    }
    float bl[16];
    if (GLA) {
        __syncthreads();
        const float bg = F.in8[l * 512 + phh * 128 + pkk];
        float wg2[16];
#pragma unroll
        for (int j = 0; j < 16; ++j) wg2[j] = W2L[j * 128 + col];
        float run = 0.f;
#pragma unroll
        for (int tt = 0; tt < 16; ++tt) { const LAS f32x4* ar = (const LAS f32x4*)(AL + (part * 16 + tt) * 16);
            const f32x4 a0 = ar[0], a1 = ar[1], a2 = ar[2], a3 = ar[3];
            float dot = bg + a0[0] * wg2[0] + a0[1] * wg2[1] + a0[2] * wg2[2] + a0[3] * wg2[3] + a1[0] * wg2[4] + a1[1] * wg2[5] + a1[2] * wg2[6] + a1[3] * wg2[7]
                      + a2[0] * wg2[8] + a2[1] * wg2[9] + a2[2] * wg2[10] + a2[3] * wg2[11] + a3[0] * wg2[12] + a3[1] * wg2[13] + a3[2] * wg2[14] + a3[3] * wg2[15];
            run += logsigmoidf_(dot) * (1.0f / 16.0f); bl[tt] = run; }
        PS[part * 128 + col] = run;
        __syncthreads();
        float off = 0.f, tot = 0.f;
#pragma unroll
        for (int p = 0; p < 4; ++p) { const float v = PS[p * 128 + col]; tot += v; off += (p < part) ? v : 0.f; }
#pragma unroll
        for (int tt = 0; tt < 16; ++tt) bl[tt] += off;
        if (part == 0) EBL[col] = __expf(tot);
    } else {
        const float lg = log1pf(-exp2f(-5.0f - (float)phh));
#pragma unroll
        for (int tt = 0; tt < 16; ++tt) bl[tt] = (float)(part * 16 + tt + 1) * lg;
        if (part == 0) EBL[col] = __expf(64.0f * lg);
    }
    {
        const float qscale = GLA ? 0.08838834764831845f : 0.125f;
        unsigned kp[8];
#pragma unroll
        for (int tt = 0; tt < 16; ++tt) { const int t = part * 16 + tt;
            const float e = __expf(bl[tt]), einv = __expf(-bl[tt]);
            const bf16_t qb = f2bf(qr[tt] * qscale * e), kb_ = f2bf(kr[tt] * einv);
            QT[(psq * 64 + t) * LDQ + pkk] = qb; KT[(psq * 64 + t) * LDQ + pkk] = kb_;
            if (tt & 1) kp[tt >> 1] |= ((unsigned)kb_) << 16; else kp[tt >> 1] = kb_; }
        LAS u32x4* d = (LAS u32x4*)(KTT + (psq * DK + pkk) * LDT + part * 16);
        d[0] = (u32x4){kp[0], kp[1], kp[2], kp[3]}; d[1] = (u32x4){kp[4], kp[5], kp[6], kp[7]};
    }
    __syncthreads();
    {
        u32x4* g = (u32x4*)(F.ws + WS_IMG + ((size_t)((GLA ? 0 : 512) + item * 32 + c)) * IMG_BYTES);
        const LAS u32x4* sI = (const LAS u32x4*)F.lds;
        for (int i = tid; i < IMG_BYTES / 16; i += 512) g[i] = sI[i];
    }
    __syncthreads();
}

template <bool GLA>
DI void mix_seq_prompt(const Ctx& F, int l, int item, int sub) {
    constexpr int DK = GLA ? 128 : 64, DV = GLA ? 256 : 128, KB = DK / 32;
    constexpr int LDQ = DK + 8, LDT = MX_LDT;
    constexpr int NCH = GLA ? 73 : 46, NCHP = GLA ? 80 : 48, BUFB = NCH * 1024;
    constexpr int C_KT = GLA ? 18432 : 9216, C_KTT = GLA ? 36864 : 18432, C_VT = GLA ? 55296 : 27648, C_EBL = GLA ? 73728 : 46080;
    int tid_ = F.tid; asm volatile("" : "+v"(tid_));
    const int tid = tid_, lane = tid & 63, wave = __builtin_amdgcn_readfirstlane(tid >> 6);
    const int b = item >> 2;
    const int hh = GLA ? (item & 3) : ((2 * item) & 7) + sub;
    const bool active = wave < 4;
    const int vs = wave & 3, r = lane & 31, h = lane >> 5;
    f32x16 S[KB];
#pragma unroll
    for (int kb = 0; kb < KB; ++kb)
#pragma unroll
        for (int i = 0; i < 16; ++i) S[kb][i] = 0.f;
    const unsigned char* img0 = F.ws + WS_IMG + ((size_t)((GLA ? 0 : 512) + item * 32)) * IMG_BYTES;
#define MX_SRC(j) (GLA ? ((j) < 54 ? (j) : ((j) < 72 ? 54 + sub * 18 + ((j) - 54) : 90)) \
                       : ((j) < 9 ? sub * 9 + (j) : ((j) < 18 ? 18 + sub * 9 + ((j) - 9) : ((j) < 27 ? 36 + sub * 9 + ((j) - 18) : ((j) < 45 ? 54 + sub * 18 + ((j) - 27) : 90)))))
#define MX_DMA(cc) do { const unsigned char* gsrc = img0 + (size_t)(cc) * IMG_BYTES + lane * 16; LAS unsigned char* dbuf = F.lds + ((cc) & 1) * BUFB; \
        for (int jj = wave; jj < NCHP; jj += 8) { const int j = jj < NCH ? jj : NCH - 1; \
            __builtin_amdgcn_global_load_lds((const unsigned*)(gsrc + MX_SRC(j) * 1024), (LAS unsigned*)(dbuf + j * 1024), 16, 0, 0); } } while (0)
    MX_DMA(0);
    for (int c = 0; c < 32; ++c) {
        const int rowbase = b * TP + c * 64;
        asm volatile("s_waitcnt vmcnt(0)" ::: "memory");
        __syncthreads();
        if (c + 1 < 32) MX_DMA(c + 1);
        if (active) {
        LAS unsigned char* base = F.lds + (c & 1) * BUFB;
        const LAS bf16_t* QTs = (const LAS bf16_t*)base; const LAS bf16_t* KTs = (const LAS bf16_t*)(base + C_KT);
        const LAS bf16_t* KTTs = (const LAS bf16_t*)(base + C_KTT); const LAS bf16_t* VTs = (const LAS bf16_t*)(base + C_VT) + vs * 32 * LDT;
        const LAS float* EBLs = (const LAS float*)(base + C_EBL) + (GLA ? 0 : sub * 64);
        f32x16 o0, o1, p00, p01, p11;
#pragma unroll
        for (int i = 0; i < 16; ++i) { p00[i] = 0.f; p01[i] = 0.f; p11[i] = 0.f; o0[i] = 0.f; o1[i] = 0.f; }
        constexpr int NG = DK / 32;
        bf16x8 ka[2][2][2], qb[2][2][2];
        s16x4 ql[2][2][2][2];
        s16x4 vl[2][2][2];
        bf16x8 vb[2], kaS[2][KB];
#define SQ_SB __builtin_amdgcn_sched_barrier(0)
#define LD_PT(bf, g) do { _Pragma("unroll") for (int q_ = 0; q_ < 2; ++q_) { const int ko = ((g) * 2 + q_) * 16 + 8 * h; \
            ka[bf][q_][0] = *(const LAS bf16x8*)(KTs + r * LDQ + ko); ka[bf][q_][1] = *(const LAS bf16x8*)(KTs + (32 + r) * LDQ + ko); \
            qb[bf][q_][0] = *(const LAS bf16x8*)(QTs + r * LDQ + ko); qb[bf][q_][1] = *(const LAS bf16x8*)(QTs + (32 + r) * LDQ + ko); } } while (0)
#define MM_PT(bf) do { _Pragma("unroll") for (int q_ = 0; q_ < 2; ++q_) { p00 = MFMA32(ka[bf][q_][0], qb[bf][q_][0], p00); p01 = MFMA32(ka[bf][q_][0], qb[bf][q_][1], p01); p11 = MFMA32(ka[bf][q_][1], qb[bf][q_][1], p11); } } while (0)
#define LD_OI(bf, kb) do { _Pragma("unroll") for (int s2 = 0; s2 < 2; ++s2) { const int kbase = (kb) * 32 + 16 * s2 + 4 * h; \
            ql[bf][s2][0][0] = *(const LAS s16x4*)(QTs + r * LDQ + kbase); ql[bf][s2][0][1] = *(const LAS s16x4*)(QTs + r * LDQ + kbase + 8); \
            ql[bf][s2][1][0] = *(const LAS s16x4*)(QTs + (32 + r) * LDQ + kbase); ql[bf][s2][1][1] = *(const LAS s16x4*)(QTs + (32 + r) * LDQ + kbase + 8); } } while (0)
#define MM_OI(bf, kb) do { _Pragma("unroll") for (int s2 = 0; s2 < 2; ++s2) { const bf16x8 xs = pack_step(S[kb], s2); \
            o0 = MFMA32(cat4(ql[bf][s2][0][0], ql[bf][s2][0][1]), xs, o0); o1 = MFMA32(cat4(ql[bf][s2][1][0], ql[bf][s2][1][1]), xs, o1); } } while (0)
#define LD_SU(bf, s16) do { vb[bf] = *(const LAS bf16x8*)(VTs + r * LDT + (s16) * 16 + 8 * h); \
            _Pragma("unroll") for (int kb = 0; kb < KB; ++kb) kaS[bf][kb] = *(const LAS bf16x8*)(KTTs + (kb * 32 + r) * LDT + (s16) * 16 + 8 * h); } while (0)
#define MM_SU(bf) do { _Pragma("unroll") for (int kb = 0; kb < KB; ++kb) S[kb] = MFMA32(kaS[bf][kb], vb[bf], S[kb]); } while (0)
        LD_PT(0, 0); SQ_SB;
#pragma unroll
        for (int g = 0; g < NG; ++g) {
            if (g + 1 < NG) LD_PT((g + 1) & 1, g + 1); else LD_OI(0, 0);
            SQ_SB; MM_PT(g & 1); SQ_SB;
        }
#pragma unroll
        for (int i = 0; i < 16; ++i) { const bool keep = crow(i, h) <= r; p00[i] = keep ? p00[i] : 0.f; p11[i] = keep ? p11[i] : 0.f; }
#pragma unroll
        for (int kb = 0; kb < KB; ++kb) {
            if (kb + 1 < KB) LD_OI((kb + 1) & 1, kb + 1);
            else {
#pragma unroll
                for (int s2 = 0; s2 < 2; ++s2) { const int sb0 = 16 * s2 + 4 * h, sb1 = 32 + 16 * s2 + 4 * h;
                    vl[s2][0][0] = *(const LAS s16x4*)(VTs + r * LDT + sb0); vl[s2][0][1] = *(const LAS s16x4*)(VTs + r * LDT + sb0 + 8);
                    vl[s2][1][0] = *(const LAS s16x4*)(VTs + r * LDT + sb1); vl[s2][1][1] = *(const LAS s16x4*)(VTs + r * LDT + sb1 + 8); }
            }
            SQ_SB; MM_OI(kb & 1, kb); SQ_SB;
        }
        LD_SU(0, 0); SQ_SB;
#pragma unroll
        for (int s2 = 0; s2 < 2; ++s2) {
            const bf16x8 vb0 = cat4(vl[s2][0][0], vl[s2][0][1]), vb1 = cat4(vl[s2][1][0], vl[s2][1][1]);
            o0 = MFMA32(pack_step(p00, s2), vb0, o0); o1 = MFMA32(pack_step(p01, s2), vb0, o1); o1 = MFMA32(pack_step(p11, s2), vb1, o1);
        }
        SQ_SB;
#pragma unroll
        for (int s16 = 0; s16 < 4; ++s16) {
            if (s16 + 1 < 4) LD_SU((s16 + 1) & 1, s16 + 1);
            SQ_SB; MM_SU(s16 & 1); SQ_SB;
        }
#undef LD_PT
#undef MM_PT
#undef LD_OI
#undef MM_OI
#undef LD_SU
#undef MM_SU
#undef SQ_SB
        {
            float eb[KB][16];
#pragma unroll
            for (int kb = 0; kb < KB; ++kb)
#pragma unroll
                for (int i = 0; i < 16; ++i) eb[kb][i] = EBLs[kb * 32 + crow(i, h)];
#pragma unroll
            for (int kb = 0; kb < KB; ++kb)
#pragma unroll
                for (int i = 0; i < 16; ++i) S[kb][i] *= eb[kb][i];
        }
        {
            bf16_t* ob = F.ocat() + (size_t)(rowbase + 4 * h) * 3072 + (GLA ? hh * 256 + sub * 128 : 1024 + hh * 128) + vs * 32 + r;
#pragma unroll
            for (int i = 0; i < 16; ++i) { const int tr = (i & 3) + 8 * (i >> 2);
                ob[(size_t)tr * 3072] = f2bf(o0[i]); ob[(size_t)(32 + tr) * 3072] = f2bf(o1[i]); }
        }
        }
    }
#undef MX_DMA
#undef MX_SRC
    if (active) {
        int lofs = 4 * h * DV + (GLA ? sub * 128 : 0) + vs * 32 + r;
        asm volatile("" : "+v"(lofs));
        float* so = (GLA ? F.out + O_GLAP + ((size_t)(l * 4 + b) * 4 + hh) * (128 * 256) : F.out + O_RETP + ((size_t)(l * 4 + b) * 8 + hh) * (64 * 128)) + lofs;
#pragma unroll
        for (int kb = 0; kb < KB; ++kb)
#pragma unroll
            for (int i = 0; i < 16; ++i) so[(kb * 32 + (i & 3) + 8 * (i >> 2)) * DV] = S[kb][i];
    }
    asm volatile("s_waitcnt vmcnt(0)" ::: "memory");
    __syncthreads();
}

template <bool GLA>
DI void mix_sample(const Ctx& F, int l, int item) {
    constexpr int DK = GLA ? 128 : 64, DV = GLA ? 256 : 128, NHD = GLA ? 4 : 8;
    constexpr int LPR = DV / 4, NG = 512 / LPR, KPG = DK / NG;
    constexpr int QOFF = GLA ? ZQA : ZQR, KOFF = GLA ? ZKA : ZKR, VOFF = GLA ? ZVA : ZVR, GOFF = GLA ? ZRA : ZGR;
    int tid_ = F.tid; asm volatile("" : "+v"(tid_));
    const int tid = tid_, lane = tid & 63, wave = __builtin_amdgcn_readfirstlane(tid >> 6);
    LAS float* QS = (LAS float*)(F.lds + 0);
    LAS float* KS = (LAS float*)(F.lds + 2048);
    LAS float* EB = (LAS float*)(F.lds + 4096);
    LAS float* VS = (LAS float*)(F.lds + 4608);
    LAS float* PL = (LAS float*)(F.lds + 8704);
    LAS float* OR = (LAS float*)(F.lds + 9216);
    const bf16_t* z = F.zb();
    const int b = item / NHD, hh = item % NHD;
    const int row0 = MP + b * 4;
    const int lq_ = GLA ? lane : (lane & 31);
    u32x2 gw_pre = {0u, 0u}; f32x4 pg_pre = {0.f, 0.f, 0.f, 0.f}, pb_pre = {0.f, 0.f, 0.f, 0.f};
    if (wave < 4) {
        gw_pre = *(const u32x2*)(z + (size_t)(row0 + wave) * NZ + GOFF + hh * DV + lq_ * 4);
        if (GLA) pg_pre = *(const f32x4*)(F.in9 + l * 1024 + hh * 256 + lq_ * 4);
        else { pg_pre = *(const f32x4*)(F.in10 + l * 1024 + hh * 128 + lq_ * 4); pb_pre = *(const f32x4*)(F.in11 + l * 1024 + hh * 128 + lq_ * 4); }
    }
    if (tid < DK) {
        const int kk = tid;
        if (GLA) {
            float wg2[16];
#pragma unroll
            for (int j = 0; j < 16; ++j) wg2[j] = F.in7[(size_t)l * 16 * 512 + j * 512 + hh * 128 + kk];
            const float bg = F.in8[l * 512 + hh * 128 + kk];
            float run = 0.f;
#pragma unroll
            for (int t = 0; t < 4; ++t) { const float* ar = F.alr() + (size_t)(row0 + t) * 16; float dot = bg;
#pragma unroll
                for (int j = 0; j < 16; ++j) dot += ar[j] * wg2[j];
                run += logsigmoidf_(dot) * (1.0f / 16.0f);
                const size_t zr = (size_t)(row0 + t) * NZ;
                QS[t * DK + kk] = bf2f(z[zr + QOFF + hh * 128 + kk]) * 0.08838834764831845f * __expf(run);
                KS[t * DK + kk] = bf2f(z[zr + KOFF + hh * 128 + kk]) * __expf(-run); }
            EB[kk] = __expf(run);
        } else {
            const float lg = log1pf(-exp2f(-5.0f - (float)hh));
            const double inv_freq = INVF_REV[kk & 31];
            const int i32 = kk & 31;
#pragma unroll
            for (int t = 0; t < 4; ++t) { const size_t zr = (size_t)(row0 + t) * NZ;
                const float q1 = bf2f(z[zr + QOFF + hh * 64 + i32]), q2 = bf2f(z[zr + QOFF + hh * 64 + 32 + i32]);
                const float k1 = bf2f(z[zr + KOFF + hh * 64 + i32]), k2 = bf2f(z[zr + KOFF + hh * 64 + 32 + i32]);
                double rev = (double)(16384 + t) * inv_freq; rev -= rint(rev);
                const float sn = __builtin_amdgcn_sinf((float)rev), cs = __builtin_amdgcn_cosf((float)rev);
                float qv, kv;
                if (kk < 32) { qv = q1 * cs - q2 * sn; kv = k1 * cs - k2 * sn; } else { qv = q1 * sn + q2 * cs; kv = k1 * sn + k2 * cs; }
                const float bt = (float)(t + 1) * lg;
                QS[t * DK + kk] = qv * 0.125f * __expf(bt); KS[t * DK + kk] = kv * __expf(-bt); }
            EB[kk] = __expf(4.0f * lg);
        }
    }
    if (tid < DV) {
#pragma unroll
        for (int t = 0; t < 4; ++t) VS[t * DV + tid] = bf2f(z[(size_t)(row0 + t) * NZ + VOFF + hh * DV + tid]);
    }
    __syncthreads();
    {
        const int pair = tid >> 5, sub = tid & 31, t = pair >> 2, s = pair & 3;
        float p = 0.f;
#pragma unroll
        for (int i = 0; i < DK / 32; ++i) p += QS[t * DK + sub + 32 * i] * KS[s * DK + sub + 32 * i];
#pragma unroll
        for (int o = 16; o >= 1; o >>= 1) p += __shfl_xor(p, o);
        if (sub == 0) PL[pair] = (s <= t) ? p : 0.f;
    }
    const int lv = tid % LPR, grp = tid / LPR;
    f32x4 vr[4];
#pragma unroll
    for (int s = 0; s < 4; ++s) vr[s] = *(const LAS f32x4*)(VS + s * DV + lv * 4);
    {
        const size_t sbase = GLA ? ((size_t)(l * 128 + b) * 4 + hh) * (128 * 256) : ((size_t)(l * 128 + b) * 8 + hh) * (64 * 128);
        const float* sin_ = (GLA ? F.in2 : F.in3) + sbase;
        float* sout = F.out + (GLA ? O_GLAS : O_RETS) + sbase;
        constexpr int KBATCH = KPG;
        f32x4 oa[4];
#pragma unroll
        for (int t = 0; t < 4; ++t) oa[t] = (f32x4){0.f, 0.f, 0.f, 0.f};
#pragma unroll 1
        for (int k0 = 0; k0 < KPG; k0 += KBATCH) {
            f32x4 st[KBATCH];
#pragma unroll
            for (int kk = 0; kk < KBATCH; ++kk) st[kk] = *(const f32x4*)(sin_ + (size_t)(grp * KPG + k0 + kk) * DV + lv * 4);
#pragma unroll
            for (int kk = 0; kk < KBATCH; ++kk) { const int k = grp * KPG + k0 + kk; f32x4 sv = st[kk];
#pragma unroll
                for (int t = 0; t < 4; ++t) oa[t] += sv * QS[t * DK + k];
#pragma unroll
                for (int s = 0; s < 4; ++s) sv += vr[s] * KS[s * DK + k];
                sv = sv * EB[k];
                *(f32x4*)(sout + (size_t)k * DV + lv * 4) = sv; }
        }
#pragma unroll
        for (int t = 0; t < 4; ++t) *(LAS f32x4*)(OR + (grp * 4 + t) * DV + lv * 4) = oa[t];
    }
    __syncthreads();
    if (wave < 4) {
        const int t = wave, lq = GLA ? lane : (lane & 31);
        f32x4 ov = {0.f, 0.f, 0.f, 0.f};
#pragma unroll
        for (int g = 0; g < NG; ++g) ov += *(const LAS f32x4*)(OR + (g * 4 + t) * DV + lq * 4);
#pragma unroll
        for (int s = 0; s < 4; ++s) ov += *(const LAS f32x4*)(VS + s * DV + lq * 4) * PL[t * 4 + s];
        const size_t row = (size_t)(row0 + t);
        const u32x2 gw = gw_pre;
        const f32x4 gt = {bflo(gw.x), bfhi(gw.x), bflo(gw.y), bfhi(gw.y)};
        f32x4 y;
        if (GLA) {
            const f32x4 pg = pg_pre;
            float ss = ov[0] * ov[0] + ov[1] * ov[1] + ov[2] * ov[2] + ov[3] * ov[3]; ss = wave_sum(ss);
            const float rstd = rsqrtf(ss * (1.0f / 256.0f) + 1e-6f);
            y = ov * rstd * pg;
        } else {
            const f32x4 pg = pg_pre, pb2 = pb_pre;
            float s1 = ov[0] + ov[1] + ov[2] + ov[3];
#pragma unroll
            for (int o = 16; o >= 1; o >>= 1) s1 += __shfl_xor(s1, o);
            const float mu = s1 * (1.0f / 128.0f);
            const f32x4 dv = ov - mu;
            float s2 = dv[0] * dv[0] + dv[1] * dv[1] + dv[2] * dv[2] + dv[3] * dv[3];
#pragma unroll
            for (int o = 16; o >= 1; o >>= 1) s2 += __shfl_xor(s2, o);
            const float rstd = rsqrtf(s2 * (1.0f / 128.0f) + 1e-5f);
            y = dv * rstd * pg + pb2;
        }
        y[0] *= siluf_(gt[0]); y[1] *= siluf_(gt[1]); y[2] *= siluf_(gt[2]); y[3] *= siluf_(gt[3]);
        u32x2 w; w.x = pk2(y[0], y[1]); w.y = pk2(y[2], y[3]);
        if (GLA || lane < 32) *(u32x2*)(F.ocat() + row * 3072 + (GLA ? 0 : 1024) + hh * DV + lq * 4) = w;
    }
    __syncthreads();
}

template <bool GLA>
DI void mix_sample_wave(const Ctx& F, int l, int item, int lane) {
    constexpr int DK = GLA ? 128 : 64, DV = GLA ? 256 : 128, NHD = GLA ? 4 : 8, NK = DK / 64, VW = DV / 64;
    constexpr int QOFF = GLA ? ZQA : ZQR, KOFF = GLA ? ZKA : ZKR, VOFF = GLA ? ZVA : ZVR, GOFF = GLA ? ZRA : ZGR;
    const bf16_t* z = F.zb();
    const int b = item / NHD, hh = item % NHD;
    const int row0 = MP + b * 4;
    float qs[4][NK], ks[4][NK], eb[NK];
    if (GLA) {
#pragma unroll
        for (int j = 0; j < NK; ++j) { const int k = lane + 64 * j;
            float w2[16];
#pragma unroll
            for (int jj = 0; jj < 16; ++jj) w2[jj] = F.in7[(size_t)l * 16 * 512 + jj * 512 + hh * 128 + k];
            const float bg = F.in8[l * 512 + hh * 128 + k];
            float run = 0.f;
#pragma unroll
            for (int t = 0; t < 4; ++t) { const float* ar = F.alr() + (size_t)(row0 + t) * 16; float dot = bg;
#pragma unroll
                for (int jj = 0; jj < 16; ++jj) dot += ar[jj] * w2[jj];
                run += logsigmoidf_(dot) * (1.0f / 16.0f);
                const size_t zr = (size_t)(row0 + t) * NZ;
                qs[t][j] = bf2f(z[zr + QOFF + hh * 128 + k]) * 0.08838834764831845f * __expf(run);
                ks[t][j] = bf2f(z[zr + KOFF + hh * 128 + k]) * __expf(-run); }
            eb[j] = __expf(run); }
    } else {
        const float lg = log1pf(-exp2f(-5.0f - (float)hh));
        const int i32 = lane & 31;
        const double inv_freq = INVF_REV[i32];
#pragma unroll
        for (int t = 0; t < 4; ++t) { const size_t zr = (size_t)(row0 + t) * NZ;
            const float q1 = bf2f(z[zr + QOFF + hh * 64 + i32]), q2 = bf2f(z[zr + QOFF + hh * 64 + 32 + i32]);
            const float k1 = bf2f(z[zr + KOFF + hh * 64 + i32]), k2 = bf2f(z[zr + KOFF + hh * 64 + 32 + i32]);
            double rev = (double)(16384 + t) * inv_freq; rev -= rint(rev);
            const float sn = __builtin_amdgcn_sinf((float)rev), cs = __builtin_amdgcn_cosf((float)rev);
            float qv, kv;
            if (lane < 32) { qv = q1 * cs - q2 * sn; kv = k1 * cs - k2 * sn; } else { qv = q1 * sn + q2 * cs; kv = k1 * sn + k2 * cs; }
            const float bt = (float)(t + 1) * lg;
            qs[t][0] = qv * 0.125f * __expf(bt); ks[t][0] = kv * __expf(-bt); }
        eb[0] = __expf(4.0f * lg);
    }
    float vv[4][VW], gt[4][VW], gn[VW], gbias[VW];
#pragma unroll
    for (int t = 0; t < 4; ++t) { const size_t zr = (size_t)(row0 + t) * NZ;
        if (GLA) { const u32x2 w = *(const u32x2*)(z + zr + VOFF + hh * DV + lane * VW), g = *(const u32x2*)(z + zr + GOFF + hh * DV + lane * VW);
            vv[t][0] = bflo(w.x); vv[t][1] = bfhi(w.x); vv[t][VW - 2] = bflo(w.y); vv[t][VW - 1] = bfhi(w.y);
            gt[t][0] = bflo(g.x); gt[t][1] = bfhi(g.x); gt[t][VW - 2] = bflo(g.y); gt[t][VW - 1] = bfhi(g.y); }
        else { const unsigned w = *(const unsigned*)(z + zr + VOFF + hh * DV + lane * VW), g = *(const unsigned*)(z + zr + GOFF + hh * DV + lane * VW);
            vv[t][0] = bflo(w); vv[t][1] = bfhi(w); gt[t][0] = bflo(g); gt[t][1] = bfhi(g); } }
#pragma unroll
    for (int e = 0; e < VW; ++e) { gn[e] = (GLA ? F.in9 : F.in10)[l * 1024 + hh * DV + lane * VW + e]; gbias[e] = GLA ? 0.f : F.in11[l * 1024 + hh * DV + lane * VW + e]; }
    float P[4][4];
#pragma unroll
    for (int t = 0; t < 4; ++t)
#pragma unroll
        for (int s2 = 0; s2 < 4; ++s2) { if (s2 <= t) { float p = 0.f;
#pragma unroll
                for (int j = 0; j < NK; ++j) p += qs[t][j] * ks[s2][j];
                P[t][s2] = wave_sum(p); } else P[t][s2] = 0.f; }
    const size_t sbase = GLA ? ((size_t)(l * 128 + b) * 4 + hh) * (128 * 256) : ((size_t)(l * 128 + b) * 8 + hh) * (64 * 128);
    const float* sin_ = (GLA ? F.in2 : F.in3) + sbase + lane * VW;
    float* sout = F.out + (GLA ? O_GLAS : O_RETS) + sbase + lane * VW;
    float o[4][VW];
#pragma unroll
    for (int t = 0; t < 4; ++t)
#pragma unroll
        for (int e = 0; e < VW; ++e) o[t][e] = 0.f;
    typedef float fvw __attribute__((ext_vector_type(VW)));
#pragma unroll
    for (int j = 0; j < NK; ++j) {
#pragma unroll 1
        for (int k0 = 0; k0 < 64; k0 += 16) {
            fvw st[16];
#pragma unroll
            for (int kk = 0; kk < 16; ++kk) st[kk] = *(const fvw*)(sin_ + (size_t)(j * 64 + k0 + kk) * DV);
#pragma unroll
            for (int kk = 0; kk < 16; ++kk) { const int kl = k0 + kk;
                fvw sv = st[kk];
                float qk[4], kq[4];
#pragma unroll
                for (int t = 0; t < 4; ++t) { qk[t] = __builtin_bit_cast(float, __builtin_amdgcn_readlane(__builtin_bit_cast(int, qs[t][j]), kl));
                                              kq[t] = __builtin_bit_cast(float, __builtin_amdgcn_readlane(__builtin_bit_cast(int, ks[t][j]), kl)); }
                const float ebk = GLA ? __builtin_bit_cast(float, __builtin_amdgcn_readlane(__builtin_bit_cast(int, eb[j]), kl)) : eb[0];
#pragma unroll
                for (int e = 0; e < VW; ++e) {
#pragma unroll
                    for (int t = 0; t < 4; ++t) o[t][e] += qk[t] * sv[e];
                    float a = sv[e];
#pragma unroll
                    for (int t = 0; t < 4; ++t) a += kq[t] * vv[t][e];
                    sv[e] = a * ebk; }
                *(fvw*)(sout + (size_t)(j * 64 + kl) * DV) = sv; }
        }
    }
#pragma unroll
    for (int t = 0; t < 4; ++t) {
        float of[VW];
#pragma unroll
        for (int e = 0; e < VW; ++e) { float a = o[t][e];
#pragma unroll
            for (int s2 = 0; s2 < 4; ++s2) a += P[t][s2] * vv[s2][e];
            of[e] = a; }
        float y[VW];
        if (GLA) {
            float ss = 0.f;
#pragma unroll
            for (int e = 0; e < VW; ++e) ss += of[e] * of[e];
            ss = wave_sum(ss);
            const float rstd = rsqrtf(ss * (1.0f / 256.0f) + 1e-6f);
#pragma unroll
            for (int e = 0; e < VW; ++e) y[e] = of[e] * rstd * gn[e];
        } else {
            float s1 = 0.f;
#pragma unroll
            for (int e = 0; e < VW; ++e) s1 += of[e];
            const float mu = wave_sum(s1) * (1.0f / 128.0f);
            float sq = 0.f;
#pragma unroll
            for (int e = 0; e < VW; ++e) { of[e] -= mu; sq += of[e] * of[e]; }
            const float rstd = rsqrtf(wave_sum(sq) * (1.0f / 128.0f) + 1e-5f);
#pragma unroll
            for (int e = 0; e < VW; ++e) y[e] = of[e] * rstd * gn[e] + gbias[e];
        }
#pragma unroll
        for (int e = 0; e < VW; ++e) y[e] *= siluf_(gt[t][e]);
        bf16_t* op = F.ocat() + (size_t)(row0 + t) * 3072 + (GLA ? 0 : 1024) + hh * DV + lane * VW;
        if (GLA) { u32x2 w; w.x = pk2(y[0], y[1]); w.y = pk2(y[VW - 2], y[VW - 1]); *(u32x2*)op = w; }
        else *(unsigned*)op = pk2(y[0], y[1]);
    }
}

DI void mix_conv(const Ctx& F, int l, int item) {
    const bf16_t* z = F.zb();
    const float* cw = F.in12 + (size_t)l * 3 * 1024;
#pragma unroll 1
    for (int i = 0; i < 4; ++i) {
        int tid_ = F.tid; asm volatile("" : "+v"(tid_));
        const int p = tid_ + 512 * i, oct = p & 127, run = p >> 7, c = oct * 8;
        const int rs = item * 64 + run * 4;
        float w0[8], w1[8], w2[8], u0[8], u1[8];
        { const f32x4 a = *(const f32x4*)(cw + c), b = *(const f32x4*)(cw + c + 4); w0[0] = a[0]; w0[1] = a[1]; w0[2] = a[2]; w0[3] = a[3]; w0[4] = b[0]; w0[5] = b[1]; w0[6] = b[2]; w0[7] = b[3]; }
        { const f32x4 a = *(const f32x4*)(cw + 1024 + c), b = *(const f32x4*)(cw + 1024 + c + 4); w1[0] = a[0]; w1[1] = a[1]; w1[2] = a[2]; w1[3] = a[3]; w1[4] = b[0]; w1[5] = b[1]; w1[6] = b[2]; w1[7] = b[3]; }
        { const f32x4 a = *(const f32x4*)(cw + 2048 + c), b = *(const f32x4*)(cw + 2048 + c + 4); w2[0] = a[0]; w2[1] = a[1]; w2[2] = a[2]; w2[3] = a[3]; w2[4] = b[0]; w2[5] = b[1]; w2[6] = b[2]; w2[7] = b[3]; }
        const bool prompt = rs < MP;
        const int t0 = prompt ? (rs & (TP - 1)) : 0;
        const int bb = prompt ? (rs >> 11) : ((rs - MP) >> 2);
        if (prompt) {
            if (t0 == 0) {
#pragma unroll
                for (int e = 0; e < 8; ++e) { u0[e] = 0.f; u1[e] = 0.f; }
            } else {
#pragma unroll
                for (int j = 0; j < 2; ++j) { const size_t zr = (size_t)(rs - 2 + j) * NZ;
                    const u32x4 cc = *(const u32x4*)(z + zr + ZCC + c), ch = *(const u32x4*)(z + zr + ZCH + c);
                    float* u = j ? u1 : u0;
                    u[0] = bflo(cc.x) * bflo(ch.x); u[1] = bfhi(cc.x) * bfhi(ch.x); u[2] = bflo(cc.y) * bflo(ch.y); u[3] = bfhi(cc.y) * bfhi(ch.y);
                    u[4] = bflo(cc.z) * bflo(ch.z); u[5] = bfhi(cc.z) * bfhi(ch.z); u[6] = bflo(cc.w) * bflo(ch.w); u[7] = bfhi(cc.w) * bfhi(ch.w); }
            }
        } else {
            const float* sc = F.in4 + ((size_t)(l * 128 + bb) * 2) * 1024 + c;
            { const f32x4 a = *(const f32x4*)(sc), b = *(const f32x4*)(sc + 4); u0[0] = a[0]; u0[1] = a[1]; u0[2] = a[2]; u0[3] = a[3]; u0[4] = b[0]; u0[5] = b[1]; u0[6] = b[2]; u0[7] = b[3]; }
            { const f32x4 a = *(const f32x4*)(sc + 1024), b = *(const f32x4*)(sc + 1024 + 4); u1[0] = a[0]; u1[1] = a[1]; u1[2] = a[2]; u1[3] = a[3]; u1[4] = b[0]; u1[5] = b[1]; u1[6] = b[2]; u1[7] = b[3]; }
        }
        const bool last_run = prompt ? (t0 + 4 == TP) : true;
        float* nc = prompt ? F.out + O_CONVP + ((size_t)(l * 4 + bb) * 2) * 1024 + c : F.out + O_CONVS + ((size_t)(l * 128 + bb) * 2) * 1024 + c;
#pragma unroll
        for (int t = 0; t < 4; ++t) { const size_t row = (size_t)(rs + t); const size_t zr = row * NZ;
            const u32x4 cc = *(const u32x4*)(z + zr + ZCC + c), ch = *(const u32x4*)(z + zr + ZCH + c), cb = *(const u32x4*)(z + zr + ZCB + c);
            float u[8], bq[8], y[8];
            u[0] = bflo(cc.x) * bflo(ch.x); u[1] = bfhi(cc.x) * bfhi(ch.x); u[2] = bflo(cc.y) * bflo(ch.y); u[3] = bfhi(cc.y) * bfhi(ch.y);
            u[4] = bflo(cc.z) * bflo(ch.z); u[5] = bfhi(cc.z) * bfhi(ch.z); u[6] = bflo(cc.w) * bflo(ch.w); u[7] = bfhi(cc.w) * bfhi(ch.w);
            bq[0] = bflo(cb.x); bq[1] = bfhi(cb.x); bq[2] = bflo(cb.y); bq[3] = bfhi(cb.y); bq[4] = bflo(cb.z); bq[5] = bfhi(cb.z); bq[6] = bflo(cb.w); bq[7] = bfhi(cb.w);
#pragma unroll
            for (int e = 0; e < 8; ++e) y[e] = bq[e] * (w0[e] * u0[e] + w1[e] * u1[e] + w2[e] * u[e]);
            u32x4 w; w.x = pk2(y[0], y[1]); w.y = pk2(y[2], y[3]); w.z = pk2(y[4], y[5]); w.w = pk2(y[6], y[7]);
            *(u32x4*)(F.ocat() + row * 3072 + 2048 + c) = w;
            if (last_run && t >= 2) { float* d = nc + (size_t)(t - 2) * 1024;
                *(f32x4*)d = (f32x4){u[0], u[1], u[2], u[3]}; *(f32x4*)(d + 4) = (f32x4){u[4], u[5], u[6], u[7]}; }
#pragma unroll
            for (int e = 0; e < 8; ++e) { u0[e] = u1[e]; u1[e] = u[e]; } }
    }
}

DI void phase_post(const Ctx& F, int l) {
    const int lane = F.lane, wave = F.wave;
    const bf16_t* z = F.zb();
    float gg[16], rw[16], rb[16];
#pragma unroll
    for (int e = 0; e < 16; ++e) { gg[e] = F.in9[l * 1024 + lane * 16 + e]; rw[e] = F.in10[l * 1024 + lane * 16 + e]; rb[e] = F.in11[l * 1024 + lane * 16 + e]; }
    for (int row = F.blk * 8 + wave; row < MP; row += F.G * 8) {
        bf16_t* orow = F.ocat() + (size_t)row * 3072;
        const bf16_t* zrow = z + (size_t)row * NZ;
#pragma unroll
        for (int part = 0; part < 2; ++part) {
            const u32x4 o0 = *(const u32x4*)(orow + part * 1024 + lane * 16), o1 = *(const u32x4*)(orow + part * 1024 + lane * 16 + 8);
            const u32x4 g0 = *(const u32x4*)(zrow + (part ? ZGR : ZRA) + lane * 16), g1 = *(const u32x4*)(zrow + (part ? ZGR : ZRA) + lane * 16 + 8);
            float v[16], gt[16];
            v[0] = bflo(o0.x); v[1] = bfhi(o0.x); v[2] = bflo(o0.y); v[3] = bfhi(o0.y); v[4] = bflo(o0.z); v[5] = bfhi(o0.z); v[6] = bflo(o0.w); v[7] = bfhi(o0.w);
            v[8] = bflo(o1.x); v[9] = bfhi(o1.x); v[10] = bflo(o1.y); v[11] = bfhi(o1.y); v[12] = bflo(o1.z); v[13] = bfhi(o1.z); v[14] = bflo(o1.w); v[15] = bfhi(o1.w);
            gt[0] = bflo(g0.x); gt[1] = bfhi(g0.x); gt[2] = bflo(g0.y); gt[3] = bfhi(g0.y); gt[4] = bflo(g0.z); gt[5] = bfhi(g0.z); gt[6] = bflo(g0.w); gt[7] = bfhi(g0.w);
            gt[8] = bflo(g1.x); gt[9] = bfhi(g1.x); gt[10] = bflo(g1.y); gt[11] = bfhi(g1.y); gt[12] = bflo(g1.z); gt[13] = bfhi(g1.z); gt[14] = bflo(g1.w); gt[15] = bfhi(g1.w);
            float y[16];
            if (part == 0) {
                float ss = 0.f;
#pragma unroll
                for (int e = 0; e < 16; ++e) ss += v[e] * v[e];
#pragma unroll
                for (int o = 8; o >= 1; o >>= 1) ss += __shfl_xor(ss, o);
                const float rstd = rsqrtf(ss * (1.0f / 256.0f) + 1e-6f);
#pragma unroll
                for (int e = 0; e < 16; ++e) y[e] = v[e] * rstd * gg[e];
            } else {
                float s1 = 0.f;
#pragma unroll
                for (int e = 0; e < 16; ++e) s1 += v[e];
#pragma unroll
                for (int o = 4; o >= 1; o >>= 1) s1 += __shfl_xor(s1, o);
                const float mu = s1 * (1.0f / 128.0f);
                float s2 = 0.f;
#pragma unroll
                for (int e = 0; e < 16; ++e) { v[e] -= mu; s2 += v[e] * v[e]; }
#pragma unroll
                for (int o = 4; o >= 1; o >>= 1) s2 += __shfl_xor(s2, o);
                const float rstd = rsqrtf(s2 * (1.0f / 128.0f) + 1e-5f);
#pragma unroll
                for (int e = 0; e < 16; ++e) y[e] = v[e] * rstd * rw[e] + rb[e];
            }
#pragma unroll
            for (int e = 0; e < 16; ++e) y[e] *= siluf_(gt[e]);
            u32x4 w0, w1;
            w0.x = pk2(y[0], y[1]); w0.y = pk2(y[2], y[3]); w0.z = pk2(y[4], y[5]); w0.w = pk2(y[6], y[7]);
            w1.x = pk2(y[8], y[9]); w1.y = pk2(y[10], y[11]); w1.z = pk2(y[12], y[13]); w1.w = pk2(y[14], y[15]);
            *(u32x4*)(orow + part * 1024 + lane * 16) = w0; *(u32x4*)(orow + part * 1024 + lane * 16 + 8) = w1;
        }
    }
    __syncthreads();
}
DI void phase_merge(const Ctx& F) {
    const int lane = F.lane, wave = F.wave;
    const bf16_t* z = F.zb(); const bf16_t* P = F.pbr(); bf16_t* mo = F.mb();
    for (int row = F.blk * 8 + wave; row < MROWS; row += F.G * 8) {
        const bf16_t* pr = P + (size_t)row * (3 * D); const bf16_t* gr = z + (size_t)row * NZ + ZGATE;
#pragma unroll
        for (int q = 0; q < 4; ++q) { const int c = q * 512 + lane * 8;
            float acc[8];
#pragma unroll
            for (int e = 0; e < 8; ++e) acc[e] = 0.f;
#pragma unroll
            for (int br = 0; br < 3; ++br) { const u32x4 pw = *(const u32x4*)(pr + br * D + c), gw = *(const u32x4*)(gr + br * D + c);
                acc[0] += sigmoidf_(bflo(gw.x)) * bflo(pw.x); acc[1] += sigmoidf_(bfhi(gw.x)) * bfhi(pw.x); acc[2] += sigmoidf_(bflo(gw.y)) * bflo(pw.y); acc[3] += sigmoidf_(bfhi(gw.y)) * bfhi(pw.y);
                acc[4] += sigmoidf_(bflo(gw.z)) * bflo(pw.z); acc[5] += sigmoidf_(bfhi(gw.z)) * bfhi(pw.z); acc[6] += sigmoidf_(bflo(gw.w)) * bflo(pw.w); acc[7] += sigmoidf_(bfhi(gw.w)) * bfhi(pw.w); }
            u32x4 w; w.x = pk2(acc[0], acc[1]); w.y = pk2(acc[2], acc[3]); w.z = pk2(acc[4], acc[5]); w.w = pk2(acc[6], acc[7]);
            *(u32x4*)(mo + (size_t)row * D + c) = w; }
    }
    __syncthreads();
}
DI void phase_prep(const Ctx& F, int l) {
    for (int it = F.blk; it < 1024; it += F.G) {
        if (it < 512) mix_prep<true>(F, l, it >> 5, it & 31);
        else mix_prep<false>(F, l, (it - 512) >> 5, it & 31);
    }
    __syncthreads();
}
DI void phase_mixer(const Ctx& F, int l) {
    const int blk = F.blk;
#ifndef PROBE_SEQ
#define PROBE_SEQ 1
#endif
#ifndef PROBE_SMP
#define PROBE_SMP 1
#endif
    if (blk < 32) { for (int rep = 0; rep < PROBE_SEQ; ++rep) mix_seq_prompt<true>(F, l, blk >> 1, blk & 1); }
    else if (blk < 64) { for (int rep = 0; rep < PROBE_SEQ; ++rep) mix_seq_prompt<false>(F, l, (blk - 32) >> 1, blk & 1); }
    else {
        const int nslots = (F.G - 64) * 8;
        for (int ws_ = (blk - 64) * 8 + F.wave; ws_ < 1536; ws_ += nslots) {
            const int g3 = ws_ / 3, r3 = ws_ - 3 * g3;
            if (r3 == 0) mix_sample_wave<true>(F, l, g3, F.lane);
            else mix_sample_wave<false>(F, l, g3 * 2 + (r3 - 1), F.lane);
        }
        for (int it = blk - 64; it < 136; it += F.G - 64) mix_conv(F, l, it);
        __syncthreads();
        phase_convert(F, l, blk - 64, F.G - 64, l == 0 ? (2 | 4 | 8) : (4 | 8));
    }
    __syncthreads();
}

#define XB_TMO      128
#define XB_XCNT(j)  (256  + 64 * (j))
#define XB_XSUB(j)  (1280 + 64 * (j))
#define XB_XGEN(j)  (2304 + 64 * (j))
#define XB_TOP      3328
#define XB_TOPGEN   3392
#define XCD_BAR_WORDS 3456
#define XB_SPIN_CAP (1u << 18)
DI unsigned xb_ld(unsigned* p)              { return __hip_atomic_load(p, __ATOMIC_RELAXED, __HIP_MEMORY_SCOPE_AGENT); }
DI unsigned xb_add(unsigned* p, unsigned v) { return __hip_atomic_fetch_add(p, v, __ATOMIC_RELAXED, __HIP_MEMORY_SCOPE_AGENT); }
DI unsigned xb_xcc_id() { return (unsigned)__builtin_amdgcn_s_getreg((3 << 11) | 20) & 0xFu; }
#define XB_SPIN(cond, bar) do { unsigned _sp = 0; while (cond) { __builtin_amdgcn_s_sleep(1); \
    if ((++_sp & 255u) == 0u) { if (xb_ld(&(bar)[XB_TMO])) break; if (_sp > XB_SPIN_CAP) { atomicAdd(&(bar)[XB_TMO], 1u); break; } } } } while (0)
struct XcdBarrier { unsigned* bar; unsigned x; volatile LAS unsigned* st; };
DI void xcd_barrier_complete(unsigned* bar, unsigned x, unsigned& nloc, unsigned& nx) {
    const unsigned G = gridDim.x * gridDim.y * gridDim.z;
    unsigned sum, cnt, mine, sp = 0u;
    for (;;) {
        sum = 0u; cnt = 0u; mine = 0u;
#pragma unroll
        for (unsigned j = 0; j < 16; ++j) { const unsigned c = xb_ld(&bar[XB_XCNT(j)]); sum += c; cnt += (c > 0u) ? 1u : 0u; mine = (j == x) ? c : mine; }
        if (sum == G) break;
        __builtin_amdgcn_s_sleep(1);
        if ((++sp & 255u) == 0u) { if (xb_ld(&bar[XB_TMO])) break; if (sp > XB_SPIN_CAP) { atomicAdd(&bar[XB_TMO], 1u); break; } }
    }
    nloc = mine > 0u ? mine : 1u; nx = cnt > 0u ? cnt : 1u;
}
DI void xcd_barrier(const XcdBarrier& b) {
    asm volatile("s_waitcnt vmcnt(0)" ::: "memory");
    __syncthreads();
    if (threadIdx.x == 0) {
        unsigned* bar = b.bar;
        __builtin_amdgcn_s_waitcnt(0);
        unsigned nloc = b.st[0], nx = b.st[1];
        if (nloc == 0u) { xcd_barrier_complete(bar, b.x, nloc, nx); b.st[0] = nloc; b.st[1] = nx; }
        const unsigned old = xb_add(&bar[XB_XSUB(b.x)], 1u);
        const unsigned gen = old / nloc;
        if (old + 1u == (gen + 1u) * nloc) {
            __builtin_amdgcn_fence(__ATOMIC_RELEASE, "agent");
            asm volatile("s_waitcnt vmcnt(0)" ::: "memory");
            const unsigned og = xb_add(&bar[XB_TOP], 1u);
            const unsigned tg = og / nx;
            if (og + 1u == (tg + 1u) * nx) xb_add(&bar[XB_TOPGEN], 1u);
            else XB_SPIN(xb_ld(&bar[XB_TOPGEN]) == tg, bar);
            __builtin_amdgcn_fence(__ATOMIC_ACQUIRE, "agent");
            xb_add(&bar[XB_XGEN(b.x)], 1u);
            asm volatile("s_waitcnt vmcnt(0)" ::: "memory");
        } else {
            XB_SPIN(xb_ld(&bar[XB_XGEN(b.x)]) == gen, bar);
            __builtin_amdgcn_fence(__ATOMIC_ACQUIRE, "agent");
            asm volatile("s_waitcnt vmcnt(0)" ::: "memory");
        }
    }
    __syncthreads();
}

DI void run_phase(const Ctx& F, int ph) {
    if (ph == 0) { if (PHON(8)) phase_convert(F, 0, F.blk, F.G, 1 | 16); if (PHON(9)) phase_norm<0>(F, 0, true); return; }
    const int q = ph - 1, l = q / 11, s_ = q - 11 * l;
    const int s = s_ == 0 ? 0 : s_ == 1 ? 8 : s_ == 2 ? 1 : s_ == 3 ? 9 : s_ == 4 ? 2 : s_ == 5 ? 10 : s_ - 3;
    switch (s) {
    case 0: if (PHON(0)) { pg8::Gemm g{F.hb(), F.wt_in(l), D}; pg8::StaticOrder S; S.init(MROWS, NZ, D, F.G, F.blk);
        pg8::EpiBf16<0> E{F.zb(), NZ, 0}; pg8::gemm_phase(F.lds, F.tid, g, S, E); } break;
    case 1: if (PHON(1)) phase_mixer(F, l); break;
    case 2: if (PHON(2)) { pg8::Gemm g{F.ocat(), F.wt_br(l), 3072}; pg8::SegOrder S; S.init(MROWS, D, F.G, F.blk);
        pg8::EpiBf16<0> E{F.pbr(), 3 * D, D}; pg8::gemm_phase(F.lds, F.tid, g, S, E);
        if (l == 0 && F.blk >= 48) phase_convert(F, 1, F.blk - 48, F.G - 48, 1); } break;
    case 3: case 6: if (PHON(3)) {
        const bool dn = (s == 6);
        pg8::Gemm g{dn ? F.zb() : F.mb(), dn ? F.wt_dn(l) : F.wt_o(l), dn ? DFF : D};
        pg8::TailOrder S; S.init(dn ? DFF : D, F.blk, dn ? 3 : 2);
        pg8::EpiRes E{(!dn && l == 0) ? F.in0 : F.xws(), F.xws(), F.part()};
        pg8::gemm_phase(F.lds, F.tid, g, S, E); } break;
    case 4: if (PHON(4)) phase_norm<1>(F, l, false); break;
    case 5: if (PHON(5)) { pg8::Gemm g{F.hb(), F.wt_up(l), D}; pg8::StaticOrder S; S.init(MROWS, DFF, D, F.G, F.blk);
        pg8::EpiBf16<1> E{F.zb(), DFF, 0}; pg8::gemm_phase(F.lds, F.tid, g, S, E);
        if (l == 0 && F.blk >= 64) phase_convert(F, 1, F.blk - 64, F.G - 64, 16 | 2); } break;
    case 8: phase_prep(F, l); break;
    case 9: phase_post(F, l); break;
    case 10: phase_merge(F); break;
    default: if (PHON(7)) { if (l == 0) phase_norm<0>(F, 1, false); else phase_norm<2>(F, 0, false); } break;
    }
}
constexpr int N_PHASES = 23;

__global__ void __launch_bounds__(512, 2) fwd_kernel(Args a) {
    extern __shared__ __attribute__((aligned(16))) unsigned char lds_raw[];
    typedef const __attribute__((address_space(4))) Args* ArgsP;
    volatile LAS unsigned* xb_st = (volatile LAS unsigned*)((LAS unsigned char*)lds_raw + LDS_XB);
    if (a.ph_hi - a.ph_lo > 1) {
        if (threadIdx.x == 0) { xb_st[0] = 0u; xb_st[1] = 0u; }
        __syncthreads();
        if (threadIdx.x == 0) (void)xb_add(&((unsigned*)(a.ws + WS_BAR))[XB_XCNT(xb_xcc_id())], 1u);
    }
    for (int ph = a.ph_lo; ph < a.ph_hi; ++ph) {
        Ctx F;
        {
            ArgsP ap = (ArgsP)__builtin_amdgcn_kernarg_segment_ptr(); asm volatile("" : "+s"(ap));
            F.in0 = ap->in[0]; F.in1 = ap->in[1]; F.in2 = ap->in[2]; F.in3 = ap->in[3]; F.in4 = ap->in[4]; F.in5 = ap->in[5]; F.in6 = ap->in[6]; F.in7 = ap->in[7]; F.in8 = ap->in[8]; F.in9 = ap->in[9]; F.in10 = ap->in[10];
            F.in11 = ap->in[11]; F.in12 = ap->in[12]; F.in13 = ap->in[13]; F.in14 = ap->in[14]; F.in15 = ap->in[15]; F.in16 = ap->in[16]; F.in17 = ap->in[17]; F.in18 = ap->in[18]; F.in19 = ap->in[19]; F.in20 = ap->in[20];
            F.out = ap->out; F.ws = ap->ws; F.lds = (LAS unsigned char*)lds_raw; F.G = gridDim.x; F.blk = blockIdx.x;
            int t_ = threadIdx.x; asm volatile("" : "+v"(t_)); F.tid = t_; F.lane = t_ & 63; F.wave = __builtin_amdgcn_readfirstlane(t_ >> 6);
        }
        run_phase(F, ph);
#ifdef PROBE_DUP
        if ((PROBE_DUP >> (ph == 0 ? 15 : ((ph - 1) % 11))) & 1) { __syncthreads(); cg::this_grid().sync(); run_phase(F, ph); }
#endif
        if (ph + 1 < a.ph_hi) {
            if (a.ph_lo < 0) cg::this_grid().sync();
            { XcdBarrier xb; xb.bar = (unsigned*)(a.ws + WS_BAR); xb.x = xb_xcc_id(); xb.st = xb_st; xcd_barrier(xb); }
        }
    }
}

extern "C" void kernel_launch(void* const* d_in, const int* in_sizes, int n_in, void* d_out, int out_size, void* d_ws, size_t ws_size, hipStream_t stream) {
    static int grid = 0;
    if (grid == 0) {
        if (n_in != 21 || ws_size < WS_END) { fprintf(stderr, "kernel_launch: need 21 inputs and >= %zu bytes of workspace (got %d, %zu)\n", (size_t)WS_END, n_in, ws_size); grid = -1; return; }
        int dev = 0, cus = 0, per_cu = 0;
        hipGetDevice(&dev);
        hipDeviceGetAttribute(&cus, hipDeviceAttributeMultiprocessorCount, dev);
        if (hipFuncSetAttribute((const void*)fwd_kernel, hipFuncAttributeMaxDynamicSharedMemorySize, LDS_BYTES) != hipSuccess) { fprintf(stderr, "kernel_launch: hipFuncSetAttribute failed\n"); grid = -1; return; }
        if (hipOccupancyMaxActiveBlocksPerMultiprocessor(&per_cu, (const void*)fwd_kernel, 512, LDS_BYTES) != hipSuccess || per_cu < 1) { fprintf(stderr, "kernel_launch: occupancy query says %d blocks per CU\n", per_cu); per_cu = 1; }
        (void)hipGetLastError();
        if (cus != 256) { fprintf(stderr, "kernel_launch: built for a 256-CU device (got %d CUs)\n", cus); grid = -1; return; }
        grid = cus;
    }
    if (grid < 0) return;
    Args a{};
    for (int i = 0; i < 21; ++i) a.in[i] = (const float*)d_in[i];
    a.out = (float*)d_out; a.ws = (unsigned char*)d_ws;
#if MK_MULTI
    for (int ph = 0; ph < N_PHASES; ++ph) { a.ph_lo = ph; a.ph_hi = ph + 1;
        hipLaunchKernelGGL(fwd_kernel, dim3(grid), dim3(512), LDS_BYTES, stream, a); }
#else
    a.ph_lo = 0; a.ph_hi = N_PHASES;
    if (hipMemsetAsync((unsigned char*)d_ws + WS_BAR, 0, 16384, stream) != hipSuccess) { fprintf(stderr, "kernel_launch: hipMemsetAsync of the barrier words failed\n"); return; }
    void* args[] = {&a};
    hipError_t e = hipLaunchCooperativeKernel((const void*)fwd_kernel, dim3(grid), dim3(512), args, LDS_BYTES, stream);
    if (e != hipSuccess) fprintf(stderr, "kernel_launch: cooperative launch failed: %s (grid %d)\n", hipGetErrorString(e), grid);
#endif
}
```

```cpp
#include <hip/hip_runtime.h>
#include <hip/hip_cooperative_groups.h>
#include <cstdio>
namespace cg = cooperative_groups;

#ifndef MK_MULTI
#define MK_MULTI 0
#endif

#ifndef PHMASK
#define PHMASK 0xffff
#endif
#define PHON(b) ((PHMASK >> (b)) & 1)
#define LAS __attribute__((address_space(3)))
#define DI __device__ __forceinline__
typedef unsigned short bf16_t;
typedef short bf16x8 __attribute__((ext_vector_type(8)));
typedef short s16x4 __attribute__((ext_vector_type(4)));
typedef float f32x2 __attribute__((ext_vector_type(2)));
typedef float f32x4 __attribute__((ext_vector_type(4)));
typedef float f32x16 __attribute__((ext_vector_type(16)));
typedef unsigned u32x4 __attribute__((ext_vector_type(4)));
typedef unsigned u32x2 __attribute__((ext_vector_type(2)));
typedef __bf16 bf16x2_t __attribute__((ext_vector_type(2)));

constexpr int D = 2048, MP = 8192, MS = 512, MROWS = 8704, TP = 2048;
constexpr int INC = 15376;
constexpr int NZ = 15360;
constexpr int ZQA = 0, ZKA = 512, ZVA = 1024, ZRA = 2048, ZQR = 3072, ZKR = 3584, ZVR = 4096, ZGR = 5120, ZCB = 6144, ZCC = 7168, ZCH = 8192, ZGATE = 9216;
constexpr int DFF = 8192;
constexpr int LDS_XB = 149504;
constexpr int LDS_BYTES = LDS_XB + 16;
constexpr size_t O_YP = 0, O_YS = 16777216, O_GLAP = 17825792, O_RETP = 18874368, O_CONVP = 19398656, O_GLAS = 19415040, O_RETS = 52969472, O_CONVS = 69746688;
constexpr size_t SZ_WIN = (size_t)NZ * D * 2, SZ_WBR = (size_t)D * 3072 * 2, SZ_WO = (size_t)D * D * 2, SZ_WUP = (size_t)DFF * D * 2, SZ_WDN = (size_t)D * DFF * 2;
constexpr size_t WS_WIN = 0, WS_WBR = WS_WIN + 2 * SZ_WIN, WS_WO = WS_WBR + 2 * SZ_WBR, WS_WUP = WS_WO + 2 * SZ_WO, WS_WDN = WS_WUP + 2 * SZ_WUP;
constexpr size_t WS_X = WS_WDN + 2 * SZ_WDN;
constexpr size_t WS_H = WS_X + (size_t)MROWS * D * 4;
constexpr size_t WS_Z = WS_H + (size_t)MROWS * D * 2;
constexpr size_t WS_ALR = WS_Z + (size_t)MROWS * NZ * 2;
constexpr size_t WS_OCAT = WS_ALR + (size_t)MROWS * 16 * 4;
constexpr size_t WS_M = WS_OCAT + (size_t)MROWS * 3072 * 2;
constexpr size_t WS_MT = WS_M + (size_t)MROWS * D * 2;
constexpr size_t WS_IMG = WS_MT + (size_t)MROWS * D * 4;
constexpr size_t WS_BAR = WS_IMG + (size_t)1024 * 93184;
constexpr size_t WS_END = WS_BAR + 16384;

__device__ const double INVF_REV[32] = {0.15915494309189535, 0.11934937021124886, 0.08949940160889101, 0.06711508300522726, 0.050329212104487035, 0.03774158471741977, 0.0283021958306234, 0.02122365276477766, 0.015915494309189534, 0.011934937021124886, 0.008949940160889102, 0.006711508300522725, 0.005032921210448704, 0.003774158471741977, 0.00283021958306234, 0.0021223652764777662, 0.0015915494309189536, 0.0011934937021124885, 0.0008949940160889102, 0.0006711508300522726, 0.0005032921210448703, 0.00037741584717419774, 0.00028302195830623395, 0.0002122365276477766, 0.00015915494309189535, 0.00011934937021124886, 8.949940160889102e-05, 6.711508300522725e-05, 5.0329212104487035e-05, 3.774158471741978e-05, 2.8302195830623396e-05, 2.122365276477766e-05};
struct Args { const float* in[21]; float* out; unsigned char* ws; int ph_lo, ph_hi; };

DI unsigned pk2(float a, float b) { f32x2 v = {a, b}; bf16x2_t r = __builtin_convertvector(v, bf16x2_t); return __builtin_bit_cast(unsigned, r); }
DI bf16_t f2bf(float a) { return (bf16_t)(pk2(a, 0.f) & 0xffffu); }
DI float bf2f(bf16_t b) { return __uint_as_float(((unsigned)b) << 16); }
DI float bflo(unsigned w) { return __uint_as_float(w << 16); }
DI float bfhi(unsigned w) { return __uint_as_float(w & 0xffff0000u); }
DI float sigmoidf_(float x) { return __builtin_amdgcn_rcpf(1.0f + __expf(-x)); }
DI float siluf_(float x) { return x * sigmoidf_(x); }
DI float logsigmoidf_(float x) { return fminf(x, 0.f) - __logf(1.0f + __expf(-fabsf(x))); }
DI int crow(int reg, int h) { return (reg & 3) + 8 * (reg >> 2) + 4 * h; }
DI bf16x8 pack_step(const f32x16& x, int s) {
    u32x4 p;
    p[0] = pk2(x[8 * s + 0], x[8 * s + 1]); p[1] = pk2(x[8 * s + 2], x[8 * s + 3]);
    p[2] = pk2(x[8 * s + 4], x[8 * s + 5]); p[3] = pk2(x[8 * s + 6], x[8 * s + 7]);
    return __builtin_bit_cast(bf16x8, p);
}
DI bf16x8 cat4(s16x4 lo, s16x4 hi) { return __builtin_shufflevector(lo, hi, 0, 1, 2, 3, 4, 5, 6, 7); }
#define MFMA32(a, b, c) __builtin_amdgcn_mfma_f32_32x32x16_bf16((a), (b), (c), 0, 0, 0)

namespace pg8 {
constexpr int BM = 256, BK = 64, HALF = 128, HTB = HALF * BK * 2, NXCD = 8, WGM = 8;
DI int lds_byte(int r, int c) { const int st = (r >> 4) * 2 + (c >> 5), rr = r & 15, cc = c & 31, ob = rr * 64 + cc * 2; return st * 1024 + (ob ^ (((ob >> 9) & 1) << 5)); }
DI void stage_rc(int b, int& R, int& C) { const int st = b / 1024, sb = b % 1024, swz = sb ^ (((sb >> 9) & 1) << 5); R = (st >> 1) * 16 + swz / 64; C = (st & 1) * 32 + (swz % 64) / 2; }
DI int perm32(int rho) { const int n = rho >> 4, i = rho & 15; return 8 * (i >> 2) + 4 * n + (i & 3); }

struct Unit { int pm, pn, kt0, nt; };
struct Gemm { const bf16_t* A; const bf16_t* Bt; int ld; };

DI void map_tile(int wgid, int nM, int nN, int& pm, int& pn) {
    const int nwg = nM * nN;
    { const int q = nwg / NXCD, r = nwg % NXCD, xcd = wgid % NXCD, off = wgid / NXCD; wgid = (xcd < r ? xcd * (q + 1) : r * (q + 1) + (xcd - r) * q) + off; }
    const int nig = WGM * nN, gid = wgid / nig, fm = gid * WGM, gsz = (nM - fm) < WGM ? (nM - fm) : WGM;
    pm = fm + ((wgid % nig) % gsz); pn = (wgid % nig) / gsz;
}
struct StaticOrder {
    int nM, nN, nwg, G, c, nt;
    DI void init(int M, int N, int K, int G_, int c_) { nM = M / BM; nN = N / BM; nwg = nM * nN; G = G_; c = c_; nt = K / BK; }
    DI bool next(int i, Unit& u) const {
        const long L = (long)i * G + c; if (L >= nwg) return false;
        map_tile((int)L, nM, nN, u.pm, u.pn); u.kt0 = 0; u.nt = nt; return true;
    }
};
struct SegOrder {
    int nM, nN, nwg, G, c;
    DI void init(int M, int N, int G_, int c_) { nM = M / BM; nN = N / BM; nwg = nM * nN; G = G_; c = c_; }
    DI bool next(int i, Unit& u) const {
        const long L = (long)i * G + c; if (L >= 3 * nwg) return false;
        const int br = (int)(L / nwg), t = (int)(L - (long)br * nwg);
        map_tile(t, nM, nN, u.pm, u.pn); u.kt0 = br * 16; u.nt = 16; return true;
    }
};
struct TailOrder {
    int c, nt, ls;
    DI void init(int K, int c_, int ls_) { c = c_; nt = K / BK; ls = ls_; }
    DI bool next(int i, Unit& u) const {
        if (i == 0) { map_tile(c, 32, 8, u.pm, u.pn); u.kt0 = 0; u.nt = nt; return true; }
        if (i == 1 && c < (16 << ls)) { const int ts = c >> ls, piece = c & ((1 << ls) - 1); u.pm = 32 + (ts >> 3); u.pn = ts & 7; u.nt = nt >> ls; u.kt0 = piece * u.nt; return true; }
        return false;
    }
};

template <int ACT> struct EpiBf16 {
    static constexpr bool PERM = true;
    bf16_t* O; int ldc; int segN;
    DI void operator()(const f32x4 (&acc)[2][2][4][2], const Unit& u, int wr, int wc, int fr, int fq) const {
        const int row0 = u.pm * BM + wr * 64 + fr, col0 = u.pn * BM + (u.kt0 >> 4) * segN + wc * 32 + 8 * fq;
#pragma unroll
        for (int ai = 0; ai < 2; ++ai)
#pragma unroll
            for (int m = 0; m < 4; ++m) { bf16_t* rowp = O + (size_t)(row0 + ai * HALF + m * 16) * ldc + col0;
#pragma unroll
                for (int bj = 0; bj < 2; ++bj) { f32x4 v0 = acc[ai][bj][m][0], v1 = acc[ai][bj][m][1];
                    if (ACT == 1) {
#pragma unroll
                        for (int j = 0; j < 4; ++j) { const float a = fmaxf(v0[j], 0.f), b = fmaxf(v1[j], 0.f); v0[j] = a * a; v1[j] = b * b; } }
                    u32x4 w; w.x = pk2(v0[0], v0[1]); w.y = pk2(v0[2], v0[3]); w.z = pk2(v1[0], v1[1]); w.w = pk2(v1[2], v1[3]);
                    *(u32x4*)(rowp + bj * HALF) = w; } }
    }
};
struct EpiRes {
    static constexpr bool PERM = false;
    const float* bp; float* out; float* part;
    DI void operator()(const f32x4 (&acc)[2][2][4][2], const Unit& u, int wr, int wc, int fr, int fq) const {
        const bool tail = u.pm >= 32;
        const size_t off0 = (size_t)((tail ? (u.kt0 / u.nt) * MS - MP : 0) + u.pm * BM + wr * 64 + fr) * D + u.pn * BM + wc * 32 + 4 * fq;
#pragma unroll
        for (int ai = 0; ai < 2; ++ai)
#pragma unroll
            for (int m = 0; m < 4; ++m) { const size_t off = off0 + (size_t)(ai * HALF + m * 16) * D;
                float* o = out + off + (tail ? (size_t)((WS_IMG - WS_X) / 4) : (size_t)0);
                if (tail) {
#pragma unroll
                    for (int bj = 0; bj < 2; ++bj)
#pragma unroll
                        for (int n = 0; n < 2; ++n) { float* p = o + bj * HALF + n * 16;
                            *(f32x4*)p = acc[ai][bj][m][n]; }
                } else {
                    const float* b = bp + off;
#pragma unroll
                    for (int bj = 0; bj < 2; ++bj)
#pragma unroll
                        for (int n = 0; n < 2; ++n) { const int c = bj * HALF + n * 16; *(f32x4*)(o + c) = *(const f32x4*)(b + c) + acc[ai][bj][m][n]; }
                }
                asm volatile("" ::: "memory"); }
    }
};
template <class Epi, class Sched>
DI void gemm_phase(LAS unsigned char* lds, const int tid, const Gemm g, const Sched& S, const Epi& E) {
    const int wid = __builtin_amdgcn_readfirstlane(tid >> 6), lane = tid & 63, wr = wid >> 2, wc = wid & 3, fr = lane & 15, fq = lane >> 4;
    const int K = g.ld;
    unsigned voffA[2], voffB[2];
#pragma unroll
    for (int i = 0; i < 2; ++i) { int R, C; stage_rc(tid * 16 + i * 8192, R, C); const int Rb = Epi::PERM ? ((R & ~31) + perm32(R & 31)) : R;
        voffA[i] = (unsigned)(R * K + C) * 2u; voffB[i] = (unsigned)(Rb * K + C) * 2u; }
    const size_t kstep = (size_t)(BK * 2);
    const size_t hstep = (size_t)HALF * K * 2;
    const size_t tstep = 2 * hstep;
    const unsigned ldsw = (unsigned)wid * 1024u;
    const int aoff = lds_byte(wr * 64 + fr, fq * 8), boff = lds_byte(wc * 32 + fr, fq * 8);
#define PG8_SA(b, h) (((b) * 2 + (h)) * HTB)
#define PG8_SB(b, h) ((4 + (b) * 2 + (h)) * HTB)
#define PG8_STAGE(bufoff, gbase, voff) do { _Pragma("unroll") for (int _i = 0; _i < 2; ++_i) \
        __builtin_amdgcn_global_load_lds((const unsigned*)((const char*)(gbase) + (voff)[_i]), (LAS unsigned*)(lds + (bufoff) + ldsw + _i * 8192), 16, 0, 0); } while (0)
#define PG8_LDA(dst, b, h) do { _Pragma("unroll") for (int m = 0; m < 4; ++m) _Pragma("unroll") for (int k = 0; k < 2; ++k) dst[m][k] = *(const LAS bf16x8*)(lds + PG8_SA(b, h) + aoff + m * 2048 + k * 1024); } while (0)
#define PG8_LDB(dst, b, h) do { _Pragma("unroll") for (int n = 0; n < 2; ++n) _Pragma("unroll") for (int k = 0; k < 2; ++k) dst[n][k] = *(const LAS bf16x8*)(lds + PG8_SB(b, h) + boff + n * 2048 + k * 1024); } while (0)
#define PG8_MMA(ai, bj, At, Bt) do { __builtin_amdgcn_s_setprio(1); _Pragma("unroll") for (int m = 0; m < 4; ++m) _Pragma("unroll") for (int n = 0; n < 2; ++n) _Pragma("unroll") for (int k = 0; k < 2; ++k) \
        acc[ai][bj][m][n] = __builtin_amdgcn_mfma_f32_16x16x32_bf16(Bt[n][k], At[m][k], acc[ai][bj][m][n], 0, 0, 0); __builtin_amdgcn_s_setprio(0); } while (0)
#define PG8_WAIT_V(n) asm volatile("s_waitcnt vmcnt(" #n ")" ::: "memory")
#define PG8_WAIT_L(n) asm volatile("s_waitcnt lgkmcnt(" #n ")" ::: "memory")
#define PG8_BAR __builtin_amdgcn_s_barrier()
#define PG8_SCHED __builtin_amdgcn_sched_barrier(0)
    Unit cur, nxt; int ui = 0;
    if (!S.next(0, cur)) return;
    f32x4 acc[2][2][4][2];
#pragma unroll
    for (int a = 0; a < 2; ++a)
#pragma unroll
        for (int b = 0; b < 2; ++b)
#pragma unroll
            for (int m = 0; m < 4; ++m)
#pragma unroll
                for (int n = 0; n < 2; ++n) acc[a][b][m][n] = (f32x4){0.f, 0.f, 0.f, 0.f};
    bf16x8 At[4][2], B0[2][2], B1[2][2];
    const char* cA = (const char*)g.A + (size_t)cur.pm * tstep + (size_t)cur.kt0 * kstep;
    const char* cB = (const char*)g.Bt + (size_t)cur.pn * tstep + (size_t)cur.kt0 * kstep;
    PG8_STAGE(PG8_SB(0, 0), cB, voffB); PG8_STAGE(PG8_SB(0, 1), cB + hstep, voffB); PG8_STAGE(PG8_SA(0, 0), cA, voffA); PG8_STAGE(PG8_SA(0, 1), cA + hstep, voffA);
    if (wr == 1) PG8_BAR;
    PG8_WAIT_V(2); PG8_BAR;
    PG8_STAGE(PG8_SB(1, 0), cB + kstep, voffB); PG8_STAGE(PG8_SA(1, 0), cA + kstep, voffA); PG8_STAGE(PG8_SB(1, 1), cB + hstep + kstep, voffB);
    PG8_WAIT_V(6); PG8_BAR;
    for (;;) {
        const bool has_next = S.next(ui + 1, nxt);
        const char* nA = has_next ? (const char*)g.A + (size_t)nxt.pm * tstep + (size_t)nxt.kt0 * kstep : cA;
        const char* nB = has_next ? (const char*)g.Bt + (size_t)nxt.pn * tstep + (size_t)nxt.kt0 * kstep : cB;
        const int nt = cur.nt;
        for (int t = 0; t < nt; t += 2) {
            const bool last = (t == nt - 2);
            const char* a1 = cA + (size_t)(t + 1) * kstep;
            const char* a2 = last ? nA : cA + (size_t)(t + 2) * kstep; const char* b2 = last ? nB : cB + (size_t)(t + 2) * kstep;
            const char* a3 = a2 + kstep; const char* b3 = b2 + kstep;
            PG8_LDB(B0, 0, 0); PG8_LDB(B1, 0, 1); PG8_SCHED; PG8_LDA(At, 0, 0); PG8_STAGE(PG8_SA(1, 1), a1 + hstep, voffA);
            PG8_WAIT_V(8); PG8_WAIT_L(0); PG8_BAR; PG8_MMA(0, 0, At, B0); PG8_MMA(0, 1, At, B1); PG8_BAR; PG8_SCHED;
            PG8_LDA(At, 0, 1); PG8_STAGE(PG8_SB(0, 0), b2, voffB); PG8_STAGE(PG8_SB(0, 1), b2 + hstep, voffB); PG8_STAGE(PG8_SA(0, 0), a2, voffA);
            PG8_WAIT_V(8); PG8_WAIT_L(0); PG8_BAR; PG8_MMA(1, 0, At, B0); PG8_MMA(1, 1, At, B1); PG8_BAR; PG8_SCHED;
            PG8_LDB(B0, 1, 0); PG8_LDB(B1, 1, 1); PG8_SCHED; PG8_LDA(At, 1, 0); PG8_STAGE(PG8_SA(0, 1), a2 + hstep, voffA);
            PG8_WAIT_V(8); PG8_WAIT_L(0); PG8_BAR; PG8_MMA(0, 0, At, B0); PG8_MMA(0, 1, At, B1); PG8_BAR; PG8_SCHED;
            PG8_LDA(At, 1, 1); PG8_STAGE(PG8_SB(1, 0), b3, voffB); PG8_STAGE(PG8_SB(1, 1), b3 + hstep, voffB); PG8_STAGE(PG8_SA(1, 0), a3, voffA);
            PG8_WAIT_V(8); PG8_WAIT_L(0); PG8_BAR; PG8_MMA(1, 0, At, B0); PG8_MMA(1, 1, At, B1); PG8_BAR; PG8_SCHED;
        }
        if (wr == 0) PG8_BAR;
        E(acc, cur, wr, wc, fr, fq);
        if (!has_next) break;
#pragma unroll
        for (int a = 0; a < 2; ++a)
#pragma unroll
            for (int b = 0; b < 2; ++b)
#pragma unroll
                for (int m = 0; m < 4; ++m)
#pragma unroll
                    for (int n = 0; n < 2; ++n) acc[a][b][m][n] = (f32x4){0.f, 0.f, 0.f, 0.f};
        cur = nxt; cA = nA; cB = nB; ++ui;
        if (wr == 1) PG8_BAR;
    }
    PG8_WAIT_V(0);
    PG8_BAR;
#undef PG8_SA
#undef PG8_SB
#undef PG8_STAGE
#undef PG8_LDA
#undef PG8_LDB
#undef PG8_MMA
#undef PG8_WAIT_V
#undef PG8_WAIT_L
#undef PG8_BAR
#undef PG8_SCHED
}
}

struct Ctx {
    const float *in0, *in1, *in2, *in3, *in4, *in5, *in6, *in7, *in8, *in9, *in10, *in11, *in12, *in13, *in14, *in15, *in16, *in17, *in18, *in19, *in20; float* out; unsigned char* ws; LAS unsigned char* lds; int tid, lane, wave, G, blk;
    DI bf16_t* wt_in(int l) const { return (bf16_t*)(ws + WS_WIN + (size_t)l * SZ_WIN); }
    DI bf16_t* wt_br(int l) const { return (bf16_t*)(ws + WS_WBR + (size_t)l * SZ_WBR); }
    DI bf16_t* wt_o(int l) const { return (bf16_t*)(ws + WS_WO + (size_t)l * SZ_WO); }
    DI bf16_t* wt_up(int l) const { return (bf16_t*)(ws + WS_WUP + (size_t)l * SZ_WUP); }
    DI bf16_t* wt_dn(int l) const { return (bf16_t*)(ws + WS_WDN + (size_t)l * SZ_WDN); }
    DI float* xws() const { return (float*)(ws + WS_X); }
    DI bf16_t* hb() const { return (bf16_t*)(ws + WS_H); }
    DI bf16_t* zb() const { return (bf16_t*)(ws + WS_Z); }
    DI float* alr() const { return (float*)(ws + WS_ALR); }
    DI bf16_t* ocat() const { return (bf16_t*)(ws + WS_OCAT); }
    DI bf16_t* mb() const { return (bf16_t*)(ws + WS_M); }
    DI bf16_t* pbr() const { return (bf16_t*)(ws + WS_MT); }
    DI float* part() const { return (float*)(ws + WS_IMG); }
};

DI void convert_tile(const Ctx& F, const float* src, int ldsrc, int n0src, bf16_t* dst, int ldd, int n0, int k0) {
    LAS bf16_t* T = (LAS bf16_t*)F.lds;
    constexpr int LT = 264;
    const int tid = F.tid;
    const int n4 = tid & 15, kr = tid >> 4;
    f32x4 v[8];
#pragma unroll
    for (int p = 0; p < 8; ++p) v[p] = *(const f32x4*)(src + (size_t)(k0 + kr + 32 * p) * ldsrc + n0src + n4 * 4);
#pragma unroll
    for (int p = 0; p < 8; ++p) { const int k = kr + 32 * p;
#pragma unroll
        for (int e = 0; e < 4; ++e) T[(n4 * 4 + e) * LT + k] = f2bf(v[p][e]); }
    __syncthreads();
    const int kc = tid & 31, nr = tid >> 5;
#pragma unroll
    for (int p = 0; p < 4; ++p) { const int n = nr + 16 * p;
        const u32x4 w = *(const LAS u32x4*)(T + n * LT + kc * 8);
        *(u32x4*)(dst + (size_t)(n0 + n) * ldd + k0 + kc * 8) = w; }
    __syncthreads();
}
DI void phase_convert(const Ctx& F, const int l, const int wg, const int nwg, const int jobs) {
    int base = 0;
#define CV_JOB(count, ...) do { for (int t = (((wg - base) % nwg) + nwg) % nwg; t < (count); t += nwg) { __VA_ARGS__; } base += (count); } while (0)
    if (jobs & 1) CV_JOB(960, { const int nt_ = t % 240, kt_ = t / 240; const int n0 = nt_ * 64; const int n0s = n0 + (n0 >= 2048 ? 16 : 0);
        convert_tile(F, F.in6 + (size_t)l * D * INC, INC, n0s, F.wt_in(l), D, n0, kt_ * 256); });
    if (jobs & 16) CV_JOB(960, { const int t2 = t + 960; const int nt_ = t2 % 240, kt_ = t2 / 240; const int n0 = nt_ * 64; const int n0s = n0 + (n0 >= 2048 ? 16 : 0);
        convert_tile(F, F.in6 + (size_t)l * D * INC, INC, n0s, F.wt_in(l), D, n0, kt_ * 256); });
    if (jobs & 2) { CV_JOB(128, { const int nt_ = t % 32, kt_ = t / 32; convert_tile(F, F.in13 + (size_t)l * 1024 * D, D, nt_ * 64, F.wt_br(l), 3072, nt_ * 64, kt_ * 256); });
    CV_JOB(128, { const int nt_ = t % 32, kt_ = t / 32; convert_tile(F, F.in14 + (size_t)l * 1024 * D, D, nt_ * 64, F.wt_br(l) + 1024, 3072, nt_ * 64, kt_ * 256); });
    CV_JOB(128, { const int nt_ = t % 32, kt_ = t / 32; convert_tile(F, F.in15 + (size_t)l * 1024 * D, D, nt_ * 64, F.wt_br(l) + 2048, 3072, nt_ * 64, kt_ * 256); });
    CV_JOB(256, { const int nt_ = t % 32, kt_ = t / 32; convert_tile(F, F.in16 + (size_t)l * D * D, D, nt_ * 64, F.wt_o(l), D, nt_ * 64, kt_ * 256); }); }
    if (jobs & 4) { CV_JOB(1024, { const int nt_ = t % 128, kt_ = t / 128; convert_tile(F, F.in18 + (size_t)l * D * DFF, DFF, nt_ * 64, F.wt_up(l), D, nt_ * 64, kt_ * 256); }); }
    if (jobs & 8) { CV_JOB(1024, { const int nt_ = t % 32, kt_ = t / 32; convert_tile(F, F.in19 + (size_t)l * DFF * D, D, nt_ * 64, F.wt_dn(l), DFF, nt_ * 64, kt_ * 256); }); }
#undef CV_JOB
}

DI float wave_sum(float v) {
#pragma unroll
    for (int o = 32; o >= 1; o >>= 1) v += __shfl_xor(v, o);
    return v;
}
template <int MODE>
DI void norm_row(const Ctx& F, int row, bool from_input, const f32x4 (&gv)[8], f32x4 (&xv)[8], int lane) {
    const float* xr = from_input ? ((row < MP) ? F.in0 + (size_t)row * D : F.in1 + (size_t)(row - MP) * D) : F.xws() + (size_t)row * D;
#pragma unroll
    for (int i = 0; i < 8; ++i) xv[i] = *(const f32x4*)(xr + i * 256 + lane * 4);
    if (!from_input && row >= MP) {
#pragma unroll 1
        for (int p = 0; p < (MODE == 1 ? 4 : 8); ++p) { const float* pr = F.part() + ((size_t)p * MS + (row - MP)) * D;
#pragma unroll
            for (int i = 0; i < 8; ++i) xv[i] += *(const f32x4*)(pr + i * 256 + lane * 4); }
        float* xo = F.xws() + (size_t)row * D;
#pragma unroll
        for (int i = 0; i < 8; ++i) *(f32x4*)(xo + i * 256 + lane * 4) = xv[i];
    }
    if (MODE == 0 && from_input && row >= MP) {
        float* xo = F.xws() + (size_t)row * D;
#pragma unroll
        for (int i = 0; i < 8; ++i) *(f32x4*)(xo + i * 256 + lane * 4) = xv[i];
    }
    float ss = 0.f;
#pragma unroll
    for (int i = 0; i < 8; ++i) ss += xv[i][0] * xv[i][0] + xv[i][1] * xv[i][1] + xv[i][2] * xv[i][2] + xv[i][3] * xv[i][3];
    ss = wave_sum(ss);
    const float rstd = rsqrtf(ss * (1.0f / 2048.0f) + 1e-6f);
#pragma unroll
    for (int i = 0; i < 8; ++i) xv[i] = xv[i] * rstd * gv[i];
    if (MODE == 2) {
        float* o = F.out + O_YP + (size_t)row * D;
#pragma unroll
        for (int i = 0; i < 8; ++i) *(f32x4*)(o + i * 256 + lane * 4) = xv[i];
    } else {
        bf16_t* o = F.hb() + (size_t)row * D;
#pragma unroll
        for (int i = 0; i < 8; ++i) { u32x2 w; w.x = pk2(xv[i][0], xv[i][1]); w.y = pk2(xv[i][2], xv[i][3]); *(u32x2*)(o + i * 256 + lane * 4) = w; }
    }
}
template <int MODE>
DI void phase_norm(const Ctx& F, int l, bool from_input) {
    const int tid = F.tid, lane = F.lane, wave = F.wave;
    LAS float* WL = (LAS float*)F.lds;
    if (MODE == 0) {
        const float* w = F.in6 + (size_t)l * D * INC + 2048;
        for (int idx = tid; idx < 2048 * 4; idx += 512) { const int k = idx >> 2, j4 = idx & 3;
            const f32x4 v = *(const f32x4*)(w + (size_t)k * INC + j4 * 4);
            WL[(j4 * 4 + 0) * 2048 + k] = v[0]; WL[(j4 * 4 + 1) * 2048 + k] = v[1]; WL[(j4 * 4 + 2) * 2048 + k] = v[2]; WL[(j4 * 4 + 3) * 2048 + k] = v[3]; }
        __syncthreads();
    }
    const float* gain = (MODE == 0) ? F.in5 + l * D : (MODE == 1) ? F.in17 + l * D : F.in20;
    f32x4 gv[8];
#pragma unroll
    for (int i = 0; i < 8; ++i) gv[i] = *(const f32x4*)(gain + i * 256 + lane * 4);
    const int wslot = F.blk * 8 + wave;
    if (MODE != 0) {
        for (int it = 0; it < 5; ++it) {
            int row = it * 2048 + wslot;
            if (it == 4) { if (wslot & 3) break; row = MP + (wslot >> 2); }
            f32x4 xv[8];
            norm_row<MODE>(F, row, from_input, gv, xv, lane);
        }
    } else {
        for (int pr = 0; pr < 3; ++pr) {
            int row0 = 2 * pr * 2048 + wslot, row1 = row0 + 2048; bool two = true;
            if (pr == 2) { if (wslot & 3) break; row0 = MP + (wslot >> 2); row1 = row0; two = false; }
            f32x4 xa[8], xb[8];
            norm_row<MODE>(F, row0, from_input, gv, xa, lane);
            if (two) norm_row<MODE>(F, row1, from_input, gv, xb, lane);
            else {
#pragma unroll
                for (int i = 0; i < 8; ++i) xb[i] = xa[i];
            }
            float r0 = 0.f, r1 = 0.f;
#pragma unroll 1
            for (int j0 = 0; j0 < 16; j0 += 2) {
                float sv[4];
#pragma unroll
                for (int jj = 0; jj < 2; ++jj) { float s0 = 0.f, s1 = 0.f;
#pragma unroll
                    for (int i = 0; i < 8; ++i) { const f32x4 w = *(const LAS f32x4*)(WL + (j0 + jj) * 2048 + i * 256 + lane * 4);
                        s0 += xa[i][0] * w[0] + xa[i][1] * w[1] + xa[i][2] * w[2] + xa[i][3] * w[3];
                        s1 += xb[i][0] * w[0] + xb[i][1] * w[1] + xb[i][2] * w[2] + xb[i][3] * w[3]; }
                    sv[2 * jj] = s0; sv[2 * jj + 1] = s1; }
#pragma unroll
                for (int o = 32; o >= 1; o >>= 1) {
                    float t[4];
#pragma unroll
                    for (int e = 0; e < 4; ++e) t[e] = __shfl_xor(sv[e], o);
#pragma unroll
                    for (int e = 0; e < 4; ++e) sv[e] += t[e];
                }
#pragma unroll
                for (int jj = 0; jj < 2; ++jj) { r0 = (lane == j0 + jj) ? sv[2 * jj] : r0; r1 = (lane == j0 + jj) ? sv[2 * jj + 1] : r1; }
            }
            if (lane < 16) { F.alr()[(size_t)row0 * 16 + lane] = r0; if (two) F.alr()[(size_t)row1 * 16 + lane] = r1; }
        }
    }
    __syncthreads();
}

constexpr int MX_QT = 0, MX_KT = 18432, MX_KTT = 36864, MX_VT = 55296, MX_EBL = 92160, MX_LDT = 72;
constexpr int IMG_BYTES = 93184;
constexpr int MX_PS = 93184, MX_AL = 95232, MX_W2 = 99328;
constexpr int MX_OSB = 93184, MX_LDOB = 264;

template <bool GLA>
DI void mix_prep(const Ctx& F, int l, int item, int c) {
    constexpr int DK = GLA ? 128 : 64;
    constexpr int LDQ = DK + 8, LDT = MX_LDT;
    constexpr int QOFF = GLA ? ZQA : ZQR, KOFF = GLA ? ZKA : ZKR, VOFF = GLA ? ZVA : ZVR;
    int tid_ = F.tid; asm volatile("" : "+v"(tid_));
    const int tid = tid_;
    LAS bf16_t* QT = (LAS bf16_t*)(F.lds + MX_QT);
    LAS bf16_t* KT = (LAS bf16_t*)(F.lds + MX_KT);
    LAS bf16_t* KTT = (LAS bf16_t*)(F.lds + MX_KTT);
    LAS bf16_t* VT = (LAS bf16_t*)(F.lds + MX_VT);
    LAS float* EBL = (LAS float*)(F.lds + MX_EBL);
    LAS float* PS = (LAS float*)(F.lds + MX_PS);
    LAS float* AL = (LAS float*)(F.lds + MX_AL);
    LAS float* W2L = (LAS float*)(F.lds + MX_W2);
    const bf16_t* z = F.zb();
    const int b = item >> 2;
    const int hh0 = GLA ? (item & 3) : ((2 * item) & 7);
    const int col = tid & 127, part = __builtin_amdgcn_readfirstlane(tid >> 7);
    const int psq = GLA ? 0 : (col >> 6), pkk = GLA ? col : (col & 63);
    const int phh = hh0 + psq;
    const int rowbase = b * TP + c * 64;
    if (GLA) {
#pragma unroll
        for (int jj = 0; jj < 4; ++jj) W2L[(part * 4 + jj) * 128 + col] = F.in7[(size_t)l * 16 * 512 + (part * 4 + jj) * 512 + phh * 128 + pkk];
        if (tid < 256) ((LAS f32x4*)AL)[tid] = ((const f32x4*)(F.alr() + (size_t)rowbase * 16))[tid];
    }
    {
        const int trow = tid & 15, vc = tid >> 4;
        const int zc = VOFF + (GLA ? hh0 * 256 : hh0 * 128) + vc * 8;
        u32x4 w[4];
#pragma unroll
        for (int p = 0; p < 4; ++p) w[p] = *(const u32x4*)(z + (size_t)(rowbase + trow + 16 * p) * NZ + zc);
#pragma unroll
        for (int p = 0; p < 4; ++p) { const int s = trow + 16 * p; LAS bf16_t* d = VT + (vc * 8) * LDT + s;
            d[0 * LDT] = (bf16_t)(w[p].x & 0xffffu); d[1 * LDT] = (bf16_t)(w[p].x >> 16); d[2 * LDT] = (bf16_t)(w[p].y & 0xffffu); d[3 * LDT] = (bf16_t)(w[p].y >> 16);
            d[4 * LDT] = (bf16_t)(w[p].z & 0xffffu); d[5 * LDT] = (bf16_t)(w[p].z >> 16); d[6 * LDT] = (bf16_t)(w[p].w & 0xffffu); d[7 * LDT] = (bf16_t)(w[p].w >> 16); }
    }
    float qr[16], kr[16];
    {
        const int i32 = pkk & 31;
#pragma unroll
        for (int tt = 0; tt < 16; ++tt) { const size_t zr = (size_t)(rowbase + part * 16 + tt) * NZ;
            if (GLA) { qr[tt] = bf2f(z[zr + QOFF + phh * 128 + pkk]); kr[tt] = bf2f(z[zr + KOFF + phh * 128 + pkk]); }
            else {
                const float q1 = bf2f(z[zr + QOFF + phh * 64 + i32]), q2 = bf2f(z[zr + QOFF + phh * 64 + 32 + i32]);
                const float k1 = bf2f(z[zr + KOFF + phh * 64 + i32]), k2 = bf2f(z[zr + KOFF + phh * 64 + 32 + i32]);
                double rev = (double)(c * 64 + part * 16 + tt) * INVF_REV[i32]; rev -= rint(rev);
                const float sn = __builtin_amdgcn_sinf((float)rev), cs = __builtin_amdgcn_cosf((float)rev);
                if (pkk < 32) { qr[tt] = q1 * cs - q2 * sn; kr[tt] = k1 * cs - k2 * sn; } else { qr[tt] = q1 * sn + q2 * cs; kr[tt] = k1 * sn + k2 * cs; }
            } }
    }
    float bl[16];
    if (GLA) {
        __syncthreads();
        const float bg = F.in8[l * 512 + phh * 128 + pkk];
        float wg2[16];
#pragma unroll
        for (int j = 0; j < 16; ++j) wg2[j] = W2L[j * 128 + col];
        float run = 0.f;
#pragma unroll
        for (int tt = 0; tt < 16; ++tt) { const LAS f32x4* ar = (const LAS f32x4*)(AL + (part * 16 + tt) * 16);
            const f32x4 a0 = ar[0], a1 = ar[1], a2 = ar[2], a3 = ar[3];
            float dot = bg + a0[0] * wg2[0] + a0[1] * wg2[1] + a0[2] * wg2[2] + a0[3] * wg2[3] + a1[0] * wg2[4] + a1[1] * wg2[5] + a1[2] * wg2[6] + a1[3] * wg2[7]
                      + a2[0] * wg2[8] + a2[1] * wg2[9] + a2[2] * wg2[10] + a2[3] * wg2[11] + a3[0] * wg2[12] + a3[1] * wg2[13] + a3[2] * wg2[14] + a3[3] * wg2[15];
            run += logsigmoidf_(dot) * (1.0f / 16.0f); bl[tt] = run; }
        PS[part * 128 + col] = run;
        __syncthreads();
        float off = 0.f, tot = 0.f;
#pragma unroll
        for (int p = 0; p < 4; ++p) { const float v = PS[p * 128 + col]; tot += v; off += (p < part) ? v : 0.f; }
#pragma unroll
        for (int tt = 0; tt < 16; ++tt) bl[tt] += off;
        if (part == 0) EBL[col] = __expf(tot);
    } else {
        const float lg = log1pf(-exp2f(-5.0f - (float)phh));
#pragma unroll
        for (int tt = 0; tt < 16; ++tt) bl[tt] = (float)(part * 16 + tt + 1) * lg;
        if (part == 0) EBL[col] = __expf(64.0f * lg);
    }
    {
        const float qscale = GLA ? 0.08838834764831845f : 0.125f;
        unsigned kp[8];
#pragma unroll
        for (int tt = 0; tt < 16; ++tt) { const int t = part * 16 + tt;
            const float e = __expf(bl[tt]), einv = __expf(-bl[tt]);
            const bf16_t qb = f2bf(qr[tt] * qscale * e), kb_ = f2bf(kr[tt] * einv);
            QT[(psq * 64 + t) * LDQ + pkk] = qb; KT[(psq * 64 + t) * LDQ + pkk] = kb_;
            if (tt & 1) kp[tt >> 1] |= ((unsigned)kb_) << 16; else kp[tt >> 1] = kb_; }
        LAS u32x4* d = (LAS u32x4*)(KTT + (psq * DK + pkk) * LDT + part * 16);
        d[0] = (u32x4){kp[0], kp[1], kp[2], kp[3]}; d[1] = (u32x4){kp[4], kp[5], kp[6], kp[7]};
    }
    __syncthreads();
    {
        u32x4* g = (u32x4*)(F.ws + WS_IMG + ((size_t)((GLA ? 0 : 512) + item * 32 + c)) * IMG_BYTES);
        const LAS u32x4* sI = (const LAS u32x4*)F.lds;
        for (int i = tid; i < IMG_BYTES / 16; i += 512) g[i] = sI[i];
    }
    __syncthreads();
}

template <bool GLA>
DI void mix_seq_prompt(const Ctx& F, int l, int item, int sub) {
    constexpr int DK = GLA ? 128 : 64, DV = GLA ? 256 : 128, KB = DK / 32;
    constexpr int LDQ = DK + 8, LDT = MX_LDT;
    constexpr int NCH = GLA ? 73 : 46, NCHP = GLA ? 80 : 48, BUFB = NCH * 1024;
    constexpr int C_KT = GLA ? 18432 : 9216, C_KTT = GLA ? 36864 : 18432, C_VT = GLA ? 55296 : 27648, C_EBL = GLA ? 73728 : 46080;
    int tid_ = F.tid; asm volatile("" : "+v"(tid_));
    const int tid = tid_, lane = tid & 63, wave = __builtin_amdgcn_readfirstlane(tid >> 6);
    const int b = item >> 2;
    const int hh = GLA ? (item & 3) : ((2 * item) & 7) + sub;
    const bool active = wave < 4;
    const int vs = wave & 3, r = lane & 31, h = lane >> 5;
    f32x16 S[KB];
#pragma unroll
    for (int kb = 0; kb < KB; ++kb)
#pragma unroll
        for (int i = 0; i < 16; ++i) S[kb][i] = 0.f;
    const unsigned char* img0 = F.ws + WS_IMG + ((size_t)((GLA ? 0 : 512) + item * 32)) * IMG_BYTES;
#define MX_SRC(j) (GLA ? ((j) < 54 ? (j) : ((j) < 72 ? 54 + sub * 18 + ((j) - 54) : 90)) \
                       : ((j) < 9 ? sub * 9 + (j) : ((j) < 18 ? 18 + sub * 9 + ((j) - 9) : ((j) < 27 ? 36 + sub * 9 + ((j) - 18) : ((j) < 45 ? 54 + sub * 18 + ((j) - 27) : 90)))))
#define MX_DMA(cc) do { const unsigned char* gsrc = img0 + (size_t)(cc) * IMG_BYTES + lane * 16; LAS unsigned char* dbuf = F.lds + ((cc) & 1) * BUFB; \
        for (int jj = wave; jj < NCHP; jj += 8) { const int j = jj < NCH ? jj : NCH - 1; \
            __builtin_amdgcn_global_load_lds((const unsigned*)(gsrc + MX_SRC(j) * 1024), (LAS unsigned*)(dbuf + j * 1024), 16, 0, 0); } } while (0)
    MX_DMA(0);
    for (int c = 0; c < 32; ++c) {
        const int rowbase = b * TP + c * 64;
        asm volatile("s_waitcnt vmcnt(0)" ::: "memory");
        __syncthreads();
        if (c + 1 < 32) MX_DMA(c + 1);
        if (active) {
        LAS unsigned char* base = F.lds + (c & 1) * BUFB;
        const LAS bf16_t* QTs = (const LAS bf16_t*)base; const LAS bf16_t* KTs = (const LAS bf16_t*)(base + C_KT);
        const LAS bf16_t* KTTs = (const LAS bf16_t*)(base + C_KTT); const LAS bf16_t* VTs = (const LAS bf16_t*)(base + C_VT) + vs * 32 * LDT;
        const LAS float* EBLs = (const LAS float*)(base + C_EBL) + (GLA ? 0 : sub * 64);
        f32x16 o0, o1, p00, p01, p11;
#pragma unroll
        for (int i = 0; i < 16; ++i) { p00[i] = 0.f; p01[i] = 0.f; p11[i] = 0.f; o0[i] = 0.f; o1[i] = 0.f; }
        constexpr int NG = DK / 32;
        bf16x8 ka[2][2][2], qb[2][2][2];
        s16x4 ql[2][2][2][2];
        s16x4 vl[2][2][2];
        bf16x8 vb[2], kaS[2][KB];
#define SQ_SB __builtin_amdgcn_sched_barrier(0)
#define LD_PT(bf, g) do { _Pragma("unroll") for (int q_ = 0; q_ < 2; ++q_) { const int ko = ((g) * 2 + q_) * 16 + 8 * h; \
            ka[bf][q_][0] = *(const LAS bf16x8*)(KTs + r * LDQ + ko); ka[bf][q_][1] = *(const LAS bf16x8*)(KTs + (32 + r) * LDQ + ko); \
            qb[bf][q_][0] = *(const LAS bf16x8*)(QTs + r * LDQ + ko); qb[bf][q_][1] = *(const LAS bf16x8*)(QTs + (32 + r) * LDQ + ko); } } while (0)
#define MM_PT(bf) do { _Pragma("unroll") for (int q_ = 0; q_ < 2; ++q_) { p00 = MFMA32(ka[bf][q_][0], qb[bf][q_][0], p00); p01 = MFMA32(ka[bf][q_][0], qb[bf][q_][1], p01); p11 = MFMA32(ka[bf][q_][1], qb[bf][q_][1], p11); } } while (0)
#define LD_OI(bf, kb) do { _Pragma("unroll") for (int s2 = 0; s2 < 2; ++s2) { const int kbase = (kb) * 32 + 16 * s2 + 4 * h; \
            ql[bf][s2][0][0] = *(const LAS s16x4*)(QTs + r * LDQ + kbase); ql[bf][s2][0][1] = *(const LAS s16x4*)(QTs + r * LDQ + kbase + 8); \
            ql[bf][s2][1][0] = *(const LAS s16x4*)(QTs + (32 + r) * LDQ + kbase); ql[bf][s2][1][1] = *(const LAS s16x4*)(QTs + (32 + r) * LDQ + kbase + 8); } } while (0)
#define MM_OI(bf, kb) do { _Pragma("unroll") for (int s2 = 0; s2 < 2; ++s2) { const bf16x8 xs = pack_step(S[kb], s2); \
            o0 = MFMA32(cat4(ql[bf][s2][0][0], ql[bf][s2][0][1]), xs, o0); o1 = MFMA32(cat4(ql[bf][s2][1][0], ql[bf][s2][1][1]), xs, o1); } } while (0)
#define LD_SU(bf, s16) do { vb[bf] = *(const LAS bf16x8*)(VTs + r * LDT + (s16) * 16 + 8 * h); \
            _Pragma("unroll") for (int kb = 0; kb < KB; ++kb) kaS[bf][kb] = *(const LAS bf16x8*)(KTTs + (kb * 32 + r) * LDT + (s16) * 16 + 8 * h); } while (0)
#define MM_SU(bf) do { _Pragma("unroll") for (int kb = 0; kb < KB; ++kb) S[kb] = MFMA32(kaS[bf][kb], vb[bf], S[kb]); } while (0)
        LD_PT(0, 0); SQ_SB;
#pragma unroll
        for (int g = 0; g < NG; ++g) {
            if (g + 1 < NG) LD_PT((g + 1) & 1, g + 1); else LD_OI(0, 0);
            SQ_SB; MM_PT(g & 1); SQ_SB;
        }
#pragma unroll
        for (int i = 0; i < 16; ++i) { const bool keep = crow(i, h) <= r; p00[i] = keep ? p00[i] : 0.f; p11[i] = keep ? p11[i] : 0.f; }
#pragma unroll
        for (int kb = 0; kb < KB; ++kb) {
            if (kb + 1 < KB) LD_OI((kb + 1) & 1, kb + 1);
            else {
#pragma unroll
                for (int s2 = 0; s2 < 2; ++s2) { const int sb0 = 16 * s2 + 4 * h, sb1 = 32 + 16 * s2 + 4 * h;
                    vl[s2][0][0] = *(const LAS s16x4*)(VTs + r * LDT + sb0); vl[s2][0][1] = *(const LAS s16x4*)(VTs + r * LDT + sb0 + 8);
                    vl[s2][1][0] = *(const LAS s16x4*)(VTs + r * LDT + sb1); vl[s2][1][1] = *(const LAS s16x4*)(VTs + r * LDT + sb1 + 8); }
            }
            SQ_SB; MM_OI(kb & 1, kb); SQ_SB;
        }
        LD_SU(0, 0); SQ_SB;
#pragma unroll
        for (int s2 = 0; s2 < 2; ++s2) {
            const bf16x8 vb0 = cat4(vl[s2][0][0], vl[s2][0][1]), vb1 = cat4(vl[s2][1][0], vl[s2][1][1]);
            o0 = MFMA32(pack_step(p00, s2), vb0, o0); o1 = MFMA32(pack_step(p01, s2), vb0, o1); o1 = MFMA32(pack_step(p11, s2), vb1, o1);
        }
        SQ_SB;
#pragma unroll
        for (int s16 = 0; s16 < 4; ++s16) {
            if (s16 + 1 < 4) LD_SU((s16 + 1) & 1, s16 + 1);
            SQ_SB; MM_SU(s16 & 1); SQ_SB;
        }
#undef LD_PT
#undef MM_PT
#undef LD_OI
#undef MM_OI
#undef LD_SU
#undef MM_SU
#undef SQ_SB
        {
            float eb[KB][16];
#pragma unroll
            for (int kb = 0; kb < KB; ++kb)
#pragma unroll
                for (int i = 0; i < 16; ++i) eb[kb][i] = EBLs[kb * 32 + crow(i, h)];
#pragma unroll
            for (int kb = 0; kb < KB; ++kb)
#pragma unroll
                for (int i = 0; i < 16; ++i) S[kb][i] *= eb[kb][i];
        }
        {
            bf16_t* ob = F.ocat() + (size_t)(rowbase + 4 * h) * 3072 + (GLA ? hh * 256 + sub * 128 : 1024 + hh * 128) + vs * 32 + r;
#pragma unroll
            for (int i = 0; i < 16; ++i) { const int tr = (i & 3) + 8 * (i >> 2);
                ob[(size_t)tr * 3072] = f2bf(o0[i]); ob[(size_t)(32 + tr) * 3072] = f2bf(o1[i]); }
        }
        }
    }
#undef MX_DMA
#undef MX_SRC
    if (active) {
        int lofs = 4 * h * DV + (GLA ? sub * 128 : 0) + vs * 32 + r;
        asm volatile("" : "+v"(lofs));
        float* so = (GLA ? F.out + O_GLAP + ((size_t)(l * 4 + b) * 4 + hh) * (128 * 256) : F.out + O_RETP + ((size_t)(l * 4 + b) * 8 + hh) * (64 * 128)) + lofs;
#pragma unroll
        for (int kb = 0; kb < KB; ++kb)
#pragma unroll
            for (int i = 0; i < 16; ++i) so[(kb * 32 + (i & 3) + 8 * (i >> 2)) * DV] = S[kb][i];
    }
    asm volatile("s_waitcnt vmcnt(0)" ::: "memory");
    __syncthreads();
}

template <bool GLA>
DI void mix_sample(const Ctx& F, int l, int item) {
    constexpr int DK = GLA ? 128 : 64, DV = GLA ? 256 : 128, NHD = GLA ? 4 : 8;
    constexpr int LPR = DV / 4, NG = 512 / LPR, KPG = DK / NG;
    constexpr int QOFF = GLA ? ZQA : ZQR, KOFF = GLA ? ZKA : ZKR, VOFF = GLA ? ZVA : ZVR, GOFF = GLA ? ZRA : ZGR;
    int tid_ = F.tid; asm volatile("" : "+v"(tid_));
    const int tid = tid_, lane = tid & 63, wave = __builtin_amdgcn_readfirstlane(tid >> 6);
    LAS float* QS = (LAS float*)(F.lds + 0);
    LAS float* KS = (LAS float*)(F.lds + 2048);
    LAS float* EB = (LAS float*)(F.lds + 4096);
    LAS float* VS = (LAS float*)(F.lds + 4608);
    LAS float* PL = (LAS float*)(F.lds + 8704);
    LAS float* OR = (LAS float*)(F.lds + 9216);
    const bf16_t* z = F.zb();
    const int b = item / NHD, hh = item % NHD;
    const int row0 = MP + b * 4;
    const int lq_ = GLA ? lane : (lane & 31);
    u32x2 gw_pre = {0u, 0u}; f32x4 pg_pre = {0.f, 0.f, 0.f, 0.f}, pb_pre = {0.f, 0.f, 0.f, 0.f};
    if (wave < 4) {
        gw_pre = *(const u32x2*)(z + (size_t)(row0 + wave) * NZ + GOFF + hh * DV + lq_ * 4);
        if (GLA) pg_pre = *(const f32x4*)(F.in9 + l * 1024 + hh * 256 + lq_ * 4);
        else { pg_pre = *(const f32x4*)(F.in10 + l * 1024 + hh * 128 + lq_ * 4); pb_pre = *(const f32x4*)(F.in11 + l * 1024 + hh * 128 + lq_ * 4); }
    }
    if (tid < DK) {
        const int kk = tid;
        if (GLA) {
            float wg2[16];
#pragma unroll
            for (int j = 0; j < 16; ++j) wg2[j] = F.in7[(size_t)l * 16 * 512 + j * 512 + hh * 128 + kk];
            const float bg = F.in8[l * 512 + hh * 128 + kk];
            float run = 0.f;
#pragma unroll
            for (int t = 0; t < 4; ++t) { const float* ar = F.alr() + (size_t)(row0 + t) * 16; float dot = bg;
#pragma unroll
                for (int j = 0; j < 16; ++j) dot += ar[j] * wg2[j];
                run += logsigmoidf_(dot) * (1.0f / 16.0f);
                const size_t zr = (size_t)(row0 + t) * NZ;
                QS[t * DK + kk] = bf2f(z[zr + QOFF + hh * 128 + kk]) * 0.08838834764831845f * __expf(run);
                KS[t * DK + kk] = bf2f(z[zr + KOFF + hh * 128 + kk]) * __expf(-run); }
            EB[kk] = __expf(run);
        } else {
            const float lg = log1pf(-exp2f(-5.0f - (float)hh));
            const double inv_freq = INVF_REV[kk & 31];
            const int i32 = kk & 31;
#pragma unroll
            for (int t = 0; t < 4; ++t) { const size_t zr = (size_t)(row0 + t) * NZ;
                const float q1 = bf2f(z[zr + QOFF + hh * 64 + i32]), q2 = bf2f(z[zr + QOFF + hh * 64 + 32 + i32]);
                const float k1 = bf2f(z[zr + KOFF + hh * 64 + i32]), k2 = bf2f(z[zr + KOFF + hh * 64 + 32 + i32]);
                double rev = (double)(16384 + t) * inv_freq; rev -= rint(rev);
                const float sn = __builtin_amdgcn_sinf((float)rev), cs = __builtin_amdgcn_cosf((float)rev);
                float qv, kv;
                if (kk < 32) { qv = q1 * cs - q2 * sn; kv = k1 * cs - k2 * sn; } else { qv = q1 * sn + q2 * cs; kv = k1 * sn + k2 * cs; }
                const float bt = (float)(t + 1) * lg;
                QS[t * DK + kk] = qv * 0.125f * __expf(bt); KS[t * DK + kk] = kv * __expf(-bt); }
            EB[kk] = __expf(4.0f * lg);
        }
    }
    if (tid < DV) {
#pragma unroll
        for (int t = 0; t < 4; ++t) VS[t * DV + tid] = bf2f(z[(size_t)(row0 + t) * NZ + VOFF + hh * DV + tid]);
    }
    __syncthreads();
    {
        const int pair = tid >> 5, sub = tid & 31, t = pair >> 2, s = pair & 3;
        float p = 0.f;
#pragma unroll
        for (int i = 0; i < DK / 32; ++i) p += QS[t * DK + sub + 32 * i] * KS[s * DK + sub + 32 * i];
#pragma unroll
        for (int o = 16; o >= 1; o >>= 1) p += __shfl_xor(p, o);
        if (sub == 0) PL[pair] = (s <= t) ? p : 0.f;
    }
    const int lv = tid % LPR, grp = tid / LPR;
    f32x4 vr[4];
#pragma unroll
    for (int s = 0; s < 4; ++s) vr[s] = *(const LAS f32x4*)(VS + s * DV + lv * 4);
    {
        const size_t sbase = GLA ? ((size_t)(l * 128 + b) * 4 + hh) * (128 * 256) : ((size_t)(l * 128 + b) * 8 + hh) * (64 * 128);
        const float* sin_ = (GLA ? F.in2 : F.in3) + sbase;
        float* sout = F.out + (GLA ? O_GLAS : O_RETS) + sbase;
        constexpr int KBATCH = KPG;
        f32x4 oa[4];
#pragma unroll
        for (int t = 0; t < 4; ++t) oa[t] = (f32x4){0.f, 0.f, 0.f, 0.f};
#pragma unroll 1
        for (int k0 = 0; k0 < KPG; k0 += KBATCH) {
            f32x4 st[KBATCH];
#pragma unroll
            for (int kk = 0; kk < KBATCH; ++kk) st[kk] = *(const f32x4*)(sin_ + (size_t)(grp * KPG + k0 + kk) * DV + lv * 4);
#pragma unroll
            for (int kk = 0; kk < KBATCH; ++kk) { const int k = grp * KPG + k0 + kk; f32x4 sv = st[kk];
#pragma unroll
                for (int t = 0; t < 4; ++t) oa[t] += sv * QS[t * DK + k];
#pragma unroll
                for (int s = 0; s < 4; ++s) sv += vr[s] * KS[s * DK + k];
                sv = sv * EB[k];
                *(f32x4*)(sout + (size_t)k * DV + lv * 4) = sv; }
        }
#pragma unroll
        for (int t = 0; t < 4; ++t) *(LAS f32x4*)(OR + (grp * 4 + t) * DV + lv * 4) = oa[t];
    }
    __syncthreads();
    if (wave < 4) {
        const int t = wave, lq = GLA ? lane : (lane & 31);
        f32x4 ov = {0.f, 0.f, 0.f, 0.f};
#pragma unroll
        for (int g = 0; g < NG; ++g) ov += *(const LAS f32x4*)(OR + (g * 4 + t) * DV + lq * 4);
#pragma unroll
        for (int s = 0; s < 4; ++s) ov += *(const LAS f32x4*)(VS + s * DV + lq * 4) * PL[t * 4 + s];
        const size_t row = (size_t)(row0 + t);
        const u32x2 gw = gw_pre;
        const f32x4 gt = {bflo(gw.x), bfhi(gw.x), bflo(gw.y), bfhi(gw.y)};
        f32x4 y;
        if (GLA) {
            const f32x4 pg = pg_pre;
            float ss = ov[0] * ov[0] + ov[1] * ov[1] + ov[2] * ov[2] + ov[3] * ov[3]; ss = wave_sum(ss);
            const float rstd = rsqrtf(ss * (1.0f / 256.0f) + 1e-6f);
            y = ov * rstd * pg;
        } else {
            const f32x4 pg = pg_pre, pb2 = pb_pre;
            float s1 = ov[0] + ov[1] + ov[2] + ov[3];
#pragma unroll
            for (int o = 16; o >= 1; o >>= 1) s1 += __shfl_xor(s1, o);
            const float mu = s1 * (1.0f / 128.0f);
            const f32x4 dv = ov - mu;
            float s2 = dv[0] * dv[0] + dv[1] * dv[1] + dv[2] * dv[2] + dv[3] * dv[3];
#pragma unroll
            for (int o = 16; o >= 1; o >>= 1) s2 += __shfl_xor(s2, o);
            const float rstd = rsqrtf(s2 * (1.0f / 128.0f) + 1e-5f);
            y = dv * rstd * pg + pb2;
        }
        y[0] *= siluf_(gt[0]); y[1] *= siluf_(gt[1]); y[2] *= siluf_(gt[2]); y[3] *= siluf_(gt[3]);
        u32x2 w; w.x = pk2(y[0], y[1]); w.y = pk2(y[2], y[3]);
        if (GLA || lane < 32) *(u32x2*)(F.ocat() + row * 3072 + (GLA ? 0 : 1024) + hh * DV + lq * 4) = w;
    }
    __syncthreads();
}

template <bool GLA>
DI void mix_sample_wave(const Ctx& F, int l, int item, int lane) {
    constexpr int DK = GLA ? 128 : 64, DV = GLA ? 256 : 128, NHD = GLA ? 4 : 8, NK = DK / 64, VW = DV / 64;
    constexpr int QOFF = GLA ? ZQA : ZQR, KOFF = GLA ? ZKA : ZKR, VOFF = GLA ? ZVA : ZVR, GOFF = GLA ? ZRA : ZGR;
    const bf16_t* z = F.zb();
    const int b = item / NHD, hh = item % NHD;
    const int row0 = MP + b * 4;
    float qs[4][NK], ks[4][NK], eb[NK];
    if (GLA) {
#pragma unroll
        for (int j = 0; j < NK; ++j) { const int k = lane + 64 * j;
            float w2[16];
#pragma unroll
            for (int jj = 0; jj < 16; ++jj) w2[jj] = F.in7[(size_t)l * 16 * 512 + jj * 512 + hh * 128 + k];
            const float bg = F.in8[l * 512 + hh * 128 + k];
            float run = 0.f;
#pragma unroll
            for (int t = 0; t < 4; ++t) { const float* ar = F.alr() + (size_t)(row0 + t) * 16; float dot = bg;
#pragma unroll
                for (int jj = 0; jj < 16; ++jj) dot += ar[jj] * w2[jj];
                run += logsigmoidf_(dot) * (1.0f / 16.0f);
                const size_t zr = (size_t)(row0 + t) * NZ;
                qs[t][j] = bf2f(z[zr + QOFF + hh * 128 + k]) * 0.08838834764831845f * __expf(run);
                ks[t][j] = bf2f(z[zr + KOFF + hh * 128 + k]) * __expf(-run); }
            eb[j] = __expf(run); }
    } else {
        const float lg = log1pf(-exp2f(-5.0f - (float)hh));
        const int i32 = lane & 31;
        const double inv_freq = INVF_REV[i32];
#pragma unroll
        for (int t = 0; t < 4; ++t) { const size_t zr = (size_t)(row0 + t) * NZ;
            const float q1 = bf2f(z[zr + QOFF + hh * 64 + i32]), q2 = bf2f(z[zr + QOFF + hh * 64 + 32 + i32]);
            const float k1 = bf2f(z[zr + KOFF + hh * 64 + i32]), k2 = bf2f(z[zr + KOFF + hh * 64 + 32 + i32]);
            double rev = (double)(16384 + t) * inv_freq; rev -= rint(rev);
            const float sn = __builtin_amdgcn_sinf((float)rev), cs = __builtin_amdgcn_cosf((float)rev);
            float qv, kv;
            if (lane < 32) { qv = q1 * cs - q2 * sn; kv = k1 * cs - k2 * sn; } else { qv = q1 * sn + q2 * cs; kv = k1 * sn + k2 * cs; }
            const float bt = (float)(t + 1) * lg;
            qs[t][0] = qv * 0.125f * __expf(bt); ks[t][0] = kv * __expf(-bt); }
        eb[0] = __expf(4.0f * lg);
    }
    float vv[4][VW], gt[4][VW], gn[VW], gbias[VW];
#pragma unroll
    for (int t = 0; t < 4; ++t) { const size_t zr = (size_t)(row0 + t) * NZ;
        if (GLA) { const u32x2 w = *(const u32x2*)(z + zr + VOFF + hh * DV + lane * VW), g = *(const u32x2*)(z + zr + GOFF + hh * DV + lane * VW);
            vv[t][0] = bflo(w.x); vv[t][1] = bfhi(w.x); vv[t][VW - 2] = bflo(w.y); vv[t][VW - 1] = bfhi(w.y);
            gt[t][0] = bflo(g.x); gt[t][1] = bfhi(g.x); gt[t][VW - 2] = bflo(g.y); gt[t][VW - 1] = bfhi(g.y); }
        else { const unsigned w = *(const unsigned*)(z + zr + VOFF + hh * DV + lane * VW), g = *(const unsigned*)(z + zr + GOFF + hh * DV + lane * VW);
            vv[t][0] = bflo(w); vv[t][1] = bfhi(w); gt[t][0] = bflo(g); gt[t][1] = bfhi(g); } }
#pragma unroll
    for (int e = 0; e < VW; ++e) { gn[e] = (GLA ? F.in9 : F.in10)[l * 1024 + hh * DV + lane * VW + e]; gbias[e] = GLA ? 0.f : F.in11[l * 1024 + hh * DV + lane * VW + e]; }
    float P[4][4];
#pragma unroll
    for (int t = 0; t < 4; ++t)
#pragma unroll
        for (int s2 = 0; s2 < 4; ++s2) { if (s2 <= t) { float p = 0.f;
#pragma unroll
                for (int j = 0; j < NK; ++j) p += qs[t][j] * ks[s2][j];
                P[t][s2] = wave_sum(p); } else P[t][s2] = 0.f; }
    const size_t sbase = GLA ? ((size_t)(l * 128 + b) * 4 + hh) * (128 * 256) : ((size_t)(l * 128 + b) * 8 + hh) * (64 * 128);
    const float* sin_ = (GLA ? F.in2 : F.in3) + sbase + lane * VW;
    float* sout = F.out + (GLA ? O_GLAS : O_RETS) + sbase + lane * VW;
    float o[4][VW];
#pragma unroll
    for (int t = 0; t < 4; ++t)
#pragma unroll
        for (int e = 0; e < VW; ++e) o[t][e] = 0.f;
    typedef float fvw __attribute__((ext_vector_type(VW)));
#pragma unroll
    for (int j = 0; j < NK; ++j) {
#pragma unroll 1
        for (int k0 = 0; k0 < 64; k0 += 16) {
            fvw st[16];
#pragma unroll
            for (int kk = 0; kk < 16; ++kk) st[kk] = *(const fvw*)(sin_ + (size_t)(j * 64 + k0 + kk) * DV);
#pragma unroll
            for (int kk = 0; kk < 16; ++kk) { const int kl = k0 + kk;
                fvw sv = st[kk];
                float qk[4], kq[4];
#pragma unroll
                for (int t = 0; t < 4; ++t) { qk[t] = __builtin_bit_cast(float, __builtin_amdgcn_readlane(__builtin_bit_cast(int, qs[t][j]), kl));
                                              kq[t] = __builtin_bit_cast(float, __builtin_amdgcn_readlane(__builtin_bit_cast(int, ks[t][j]), kl)); }
                const float ebk = GLA ? __builtin_bit_cast(float, __builtin_amdgcn_readlane(__builtin_bit_cast(int, eb[j]), kl)) : eb[0];
#pragma unroll
                for (int e = 0; e < VW; ++e) {
#pragma unroll
                    for (int t = 0; t < 4; ++t) o[t][e] += qk[t] * sv[e];
                    float a = sv[e];
#pragma unroll
                    for (int t = 0; t < 4; ++t) a += kq[t] * vv[t][e];
                    sv[e] = a * ebk; }
                *(fvw*)(sout + (size_t)(j * 64 + kl) * DV) = sv; }
        }
    }
#pragma unroll
    for (int t = 0; t < 4; ++t) {
        float of[VW];
#pragma unroll
        for (int e = 0; e < VW; ++e) { float a = o[t][e];
#pragma unroll
            for (int s2 = 0; s2 < 4; ++s2) a += P[t][s2] * vv[s2][e];
            of[e] = a; }
        float y[VW];
        if (GLA) {
            float ss = 0.f;
#pragma unroll
            for (int e = 0; e < VW; ++e) ss += of[e] * of[e];
            ss = wave_sum(ss);
            const float rstd = rsqrtf(ss * (1.0f / 256.0f) + 1e-6f);
#pragma unroll
            for (int e = 0; e < VW; ++e) y[e] = of[e] * rstd * gn[e];
        } else {
            float s1 = 0.f;
#pragma unroll
            for (int e = 0; e < VW; ++e) s1 += of[e];
            const float mu = wave_sum(s1) * (1.0f / 128.0f);
            float sq = 0.f;
#pragma unroll
            for (int e = 0; e < VW; ++e) { of[e] -= mu; sq += of[e] * of[e]; }
            const float rstd = rsqrtf(wave_sum(sq) * (1.0f / 128.0f) + 1e-5f);
#pragma unroll
            for (int e = 0; e < VW; ++e) y[e] = of[e] * rstd * gn[e] + gbias[e];
        }
#pragma unroll
        for (int e = 0; e < VW; ++e) y[e] *= siluf_(gt[t][e]);
        bf16_t* op = F.ocat() + (size_t)(row0 + t) * 3072 + (GLA ? 0 : 1024) + hh * DV + lane * VW;
        if (GLA) { u32x2 w; w.x = pk2(y[0], y[1]); w.y = pk2(y[VW - 2], y[VW - 1]); *(u32x2*)op = w; }
        else *(unsigned*)op = pk2(y[0], y[1]);
    }
}

DI void mix_conv(const Ctx& F, int l, int item) {
    const bf16_t* z = F.zb();
    const float* cw = F.in12 + (size_t)l * 3 * 1024;
#pragma unroll 1
    for (int i = 0; i < 4; ++i) {
        int tid_ = F.tid; asm volatile("" : "+v"(tid_));
        const int p = tid_ + 512 * i, oct = p & 127, run = p >> 7, c = oct * 8;
        const int rs = item * 64 + run * 4;
        float w0[8], w1[8], w2[8], u0[8], u1[8];
        { const f32x4 a = *(const f32x4*)(cw + c), b = *(const f32x4*)(cw + c + 4); w0[0] = a[0]; w0[1] = a[1]; w0[2] = a[2]; w0[3] = a[3]; w0[4] = b[0]; w0[5] = b[1]; w0[6] = b[2]; w0[7] = b[3]; }
        { const f32x4 a = *(const f32x4*)(cw + 1024 + c), b = *(const f32x4*)(cw + 1024 + c + 4); w1[0] = a[0]; w1[1] = a[1]; w1[2] = a[2]; w1[3] = a[3]; w1[4] = b[0]; w1[5] = b[1]; w1[6] = b[2]; w1[7] = b[3]; }
        { const f32x4 a = *(const f32x4*)(cw + 2048 + c), b = *(const f32x4*)(cw + 2048 + c + 4); w2[0] = a[0]; w2[1] = a[1]; w2[2] = a[2]; w2[3] = a[3]; w2[4] = b[0]; w2[5] = b[1]; w2[6] = b[2]; w2[7] = b[3]; }
        const bool prompt = rs < MP;
        const int t0 = prompt ? (rs & (TP - 1)) : 0;
        const int bb = prompt ? (rs >> 11) : ((rs - MP) >> 2);
        if (prompt) {
            if (t0 == 0) {
#pragma unroll
                for (int e = 0; e < 8; ++e) { u0[e] = 0.f; u1[e] = 0.f; }
            } else {
#pragma unroll
                for (int j = 0; j < 2; ++j) { const size_t zr = (size_t)(rs - 2 + j) * NZ;
                    const u32x4 cc = *(const u32x4*)(z + zr + ZCC + c), ch = *(const u32x4*)(z + zr + ZCH + c);
                    float* u = j ? u1 : u0;
                    u[0] = bflo(cc.x) * bflo(ch.x); u[1] = bfhi(cc.x) * bfhi(ch.x); u[2] = bflo(cc.y) * bflo(ch.y); u[3] = bfhi(cc.y) * bfhi(ch.y);
                    u[4] = bflo(cc.z) * bflo(ch.z); u[5] = bfhi(cc.z) * bfhi(ch.z); u[6] = bflo(cc.w) * bflo(ch.w); u[7] = bfhi(cc.w) * bfhi(ch.w); }
            }
        } else {
            const float* sc = F.in4 + ((size_t)(l * 128 + bb) * 2) * 1024 + c;
            { const f32x4 a = *(const f32x4*)(sc), b = *(const f32x4*)(sc + 4); u0[0] = a[0]; u0[1] = a[1]; u0[2] = a[2]; u0[3] = a[3]; u0[4] = b[0]; u0[5] = b[1]; u0[6] = b[2]; u0[7] = b[3]; }
            { const f32x4 a = *(const f32x4*)(sc + 1024), b = *(const f32x4*)(sc + 1024 + 4); u1[0] = a[0]; u1[1] = a[1]; u1[2] = a[2]; u1[3] = a[3]; u1[4] = b[0]; u1[5] = b[1]; u1[6] = b[2]; u1[7] = b[3]; }
        }
        const bool last_run = prompt ? (t0 + 4 == TP) : true;
        float* nc = prompt ? F.out + O_CONVP + ((size_t)(l * 4 + bb) * 2) * 1024 + c : F.out + O_CONVS + ((size_t)(l * 128 + bb) * 2) * 1024 + c;
#pragma unroll
        for (int t = 0; t < 4; ++t) { const size_t row = (size_t)(rs + t); const size_t zr = row * NZ;
            const u32x4 cc = *(const u32x4*)(z + zr + ZCC + c), ch = *(const u32x4*)(z + zr + ZCH + c), cb = *(const u32x4*)(z + zr + ZCB + c);
            float u[8], bq[8], y[8];
            u[0] = bflo(cc.x) * bflo(ch.x); u[1] = bfhi(cc.x) * bfhi(ch.x); u[2] = bflo(cc.y) * bflo(ch.y); u[3] = bfhi(cc.y) * bfhi(ch.y);
            u[4] = bflo(cc.z) * bflo(ch.z); u[5] = bfhi(cc.z) * bfhi(ch.z); u[6] = bflo(cc.w) * bflo(ch.w); u[7] = bfhi(cc.w) * bfhi(ch.w);
            bq[0] = bflo(cb.x); bq[1] = bfhi(cb.x); bq[2] = bflo(cb.y); bq[3] = bfhi(cb.y); bq[4] = bflo(cb.z); bq[5] = bfhi(cb.z); bq[6] = bflo(cb.w); bq[7] = bfhi(cb.w);
#pragma unroll
            for (int e = 0; e < 8; ++e) y[e] = bq[e] * (w0[e] * u0[e] + w1[e] * u1[e] + w2[e] * u[e]);
            u32x4 w; w.x = pk2(y[0], y[1]); w.y = pk2(y[2], y[3]); w.z = pk2(y[4], y[5]); w.w = pk2(y[6], y[7]);
            *(u32x4*)(F.ocat() + row * 3072 + 2048 + c) = w;
            if (last_run && t >= 2) { float* d = nc + (size_t)(t - 2) * 1024;
                *(f32x4*)d = (f32x4){u[0], u[1], u[2], u[3]}; *(f32x4*)(d + 4) = (f32x4){u[4], u[5], u[6], u[7]}; }
#pragma unroll
            for (int e = 0; e < 8; ++e) { u0[e] = u1[e]; u1[e] = u[e]; } }
    }
}

DI void phase_post(const Ctx& F, int l) {
    const int lane = F.lane, wave = F.wave;
    const bf16_t* z = F.zb();
    float gg[16], rw[16], rb[16];
#pragma unroll
    for (int e = 0; e < 16; ++e) { gg[e] = F.in9[l * 1024 + lane * 16 + e]; rw[e] = F.in10[l * 1024 + lane * 16 + e]; rb[e] = F.in11[l * 1024 + lane * 16 + e]; }
    for (int row = F.blk * 8 + wave; row < MP; row += F.G * 8) {
        bf16_t* orow = F.ocat() + (size_t)row * 3072;
        const bf16_t* zrow = z + (size_t)row * NZ;
#pragma unroll
        for (int part = 0; part < 2; ++part) {
            const u32x4 o0 = *(const u32x4*)(orow + part * 1024 + lane * 16), o1 = *(const u32x4*)(orow + part * 1024 + lane * 16 + 8);
            const u32x4 g0 = *(const u32x4*)(zrow + (part ? ZGR : ZRA) + lane * 16), g1 = *(const u32x4*)(zrow + (part ? ZGR : ZRA) + lane * 16 + 8);
            float v[16], gt[16];
            v[0] = bflo(o0.x); v[1] = bfhi(o0.x); v[2] = bflo(o0.y); v[3] = bfhi(o0.y); v[4] = bflo(o0.z); v[5] = bfhi(o0.z); v[6] = bflo(o0.w); v[7] = bfhi(o0.w);
            v[8] = bflo(o1.x); v[9] = bfhi(o1.x); v[10] = bflo(o1.y); v[11] = bfhi(o1.y); v[12] = bflo(o1.z); v[13] = bfhi(o1.z); v[14] = bflo(o1.w); v[15] = bfhi(o1.w);
            gt[0] = bflo(g0.x); gt[1] = bfhi(g0.x); gt[2] = bflo(g0.y); gt[3] = bfhi(g0.y); gt[4] = bflo(g0.z); gt[5] = bfhi(g0.z); gt[6] = bflo(g0.w); gt[7] = bfhi(g0.w);
            gt[8] = bflo(g1.x); gt[9] = bfhi(g1.x); gt[10] = bflo(g1.y); gt[11] = bfhi(g1.y); gt[12] = bflo(g1.z); gt[13] = bfhi(g1.z); gt[14] = bflo(g1.w); gt[15] = bfhi(g1.w);
            float y[16];
            if (part == 0) {
                float ss = 0.f;
#pragma unroll
                for (int e = 0; e < 16; ++e) ss += v[e] * v[e];
#pragma unroll
                for (int o = 8; o >= 1; o >>= 1) ss += __shfl_xor(ss, o);
                const float rstd = rsqrtf(ss * (1.0f / 256.0f) + 1e-6f);
#pragma unroll
                for (int e = 0; e < 16; ++e) y[e] = v[e] * rstd * gg[e];
            } else {
                float s1 = 0.f;
#pragma unroll
                for (int e = 0; e < 16; ++e) s1 += v[e];
#pragma unroll
                for (int o = 4; o >= 1; o >>= 1) s1 += __shfl_xor(s1, o);
                const float mu = s1 * (1.0f / 128.0f);
                float s2 = 0.f;
#pragma unroll
                for (int e = 0; e < 16; ++e) { v[e] -= mu; s2 += v[e] * v[e]; }
#pragma unroll
                for (int o = 4; o >= 1; o >>= 1) s2 += __shfl_xor(s2, o);
                const float rstd = rsqrtf(s2 * (1.0f / 128.0f) + 1e-5f);
#pragma unroll
                for (int e = 0; e < 16; ++e) y[e] = v[e] * rstd * rw[e] + rb[e];
            }
#pragma unroll
            for (int e = 0; e < 16; ++e) y[e] *= siluf_(gt[e]);
            u32x4 w0, w1;
            w0.x = pk2(y[0], y[1]); w0.y = pk2(y[2], y[3]); w0.z = pk2(y[4], y[5]); w0.w = pk2(y[6], y[7]);
            w1.x = pk2(y[8], y[9]); w1.y = pk2(y[10], y[11]); w1.z = pk2(y[12], y[13]); w1.w = pk2(y[14], y[15]);
            *(u32x4*)(orow + part * 1024 + lane * 16) = w0; *(u32x4*)(orow + part * 1024 + lane * 16 + 8) = w1;
        }
    }
    __syncthreads();
}
DI void phase_merge(const Ctx& F) {
    const int lane = F.lane, wave = F.wave;
    const bf16_t* z = F.zb(); const bf16_t* P = F.pbr(); bf16_t* mo = F.mb();
    for (int row = F.blk * 8 + wave; row < MROWS; row += F.G * 8) {
        const bf16_t* pr = P + (size_t)row * (3 * D); const bf16_t* gr = z + (size_t)row * NZ + ZGATE;
#pragma unroll
        for (int q = 0; q < 4; ++q) { const int c = q * 512 + lane * 8;
            float acc[8];
#pragma unroll
            for (int e = 0; e < 8; ++e) acc[e] = 0.f;
#pragma unroll
            for (int br = 0; br < 3; ++br) { const u32x4 pw = *(const u32x4*)(pr + br * D + c), gw = *(const u32x4*)(gr + br * D + c);
                acc[0] += sigmoidf_(bflo(gw.x)) * bflo(pw.x); acc[1] += sigmoidf_(bfhi(gw.x)) * bfhi(pw.x); acc[2] += sigmoidf_(bflo(gw.y)) * bflo(pw.y); acc[3] += sigmoidf_(bfhi(gw.y)) * bfhi(pw.y);
                acc[4] += sigmoidf_(bflo(gw.z)) * bflo(pw.z); acc[5] += sigmoidf_(bfhi(gw.z)) * bfhi(pw.z); acc[6] += sigmoidf_(bflo(gw.w)) * bflo(pw.w); acc[7] += sigmoidf_(bfhi(gw.w)) * bfhi(pw.w); }
            u32x4 w; w.x = pk2(acc[0], acc[1]); w.y = pk2(acc[2], acc[3]); w.z = pk2(acc[4], acc[5]); w.w = pk2(acc[6], acc[7]);
            *(u32x4*)(mo + (size_t)row * D + c) = w; }
    }
    __syncthreads();
}
DI void phase_prep(const Ctx& F, int l) {
    for (int it = F.blk; it < 1024; it += F.G) {
        if (it < 512) mix_prep<true>(F, l, it >> 5, it & 31);
        else mix_prep<false>(F, l, (it - 512) >> 5, it & 31);
    }
    __syncthreads();
}
DI void phase_mixer(const Ctx& F, int l) {
    const int blk = F.blk;
#ifndef PROBE_SEQ
#define PROBE_SEQ 1
#endif
#ifndef PROBE_SMP
#define PROBE_SMP 1
#endif
    if (blk < 32) { for (int rep = 0; rep < PROBE_SEQ; ++rep) mix_seq_prompt<true>(F, l, blk >> 1, blk & 1); }
    else if (blk < 64) { for (int rep = 0; rep < PROBE_SEQ; ++rep) mix_seq_prompt<false>(F, l, (blk - 32) >> 1, blk & 1); }
    else {
        const int nslots = (F.G - 64) * 8;
        for (int ws_ = (blk - 64) * 8 + F.wave; ws_ < 1536; ws_ += nslots) {
            const int g3 = ws_ / 3, r3 = ws_ - 3 * g3;
            if (r3 == 0) mix_sample_wave<true>(F, l, g3, F.lane);
            else mix_sample_wave<false>(F, l, g3 * 2 + (r3 - 1), F.lane);
        }
        for (int it = blk - 64; it < 136; it += F.G - 64) mix_conv(F, l, it);
        __syncthreads();
        phase_convert(F, l, blk - 64, F.G - 64, l == 0 ? (2 | 4 | 8) : (4 | 8));
    }
    __syncthreads();
}

#define XB_TMO      128
#define XB_XCNT(j)  (256  + 64 * (j))
#define XB_XSUB(j)  (1280 + 64 * (j))
#define XB_XGEN(j)  (2304 + 64 * (j))
#define XB_TOP      3328
#define XB_TOPGEN   3392
#define XCD_BAR_WORDS 3456
#define XB_SPIN_CAP (1u << 18)
DI unsigned xb_ld(unsigned* p)              { return __hip_atomic_load(p, __ATOMIC_RELAXED, __HIP_MEMORY_SCOPE_AGENT); }
DI unsigned xb_add(unsigned* p, unsigned v) { return __hip_atomic_fetch_add(p, v, __ATOMIC_RELAXED, __HIP_MEMORY_SCOPE_AGENT); }
DI unsigned xb_xcc_id() { return (unsigned)__builtin_amdgcn_s_getreg((3 << 11) | 20) & 0xFu; }
#define XB_SPIN(cond, bar) do { unsigned _sp = 0; while (cond) { __builtin_amdgcn_s_sleep(1); \
    if ((++_sp & 255u) == 0u) { if (xb_ld(&(bar)[XB_TMO])) break; if (_sp > XB_SPIN_CAP) { atomicAdd(&(bar)[XB_TMO], 1u); break; } } } } while (0)
struct XcdBarrier { unsigned* bar; unsigned x; volatile LAS unsigned* st; };
DI void xcd_barrier_complete(unsigned* bar, unsigned x, unsigned& nloc, unsigned& nx) {
    const unsigned G = gridDim.x * gridDim.y * gridDim.z;
    unsigned sum, cnt, mine, sp = 0u;
    for (;;) {
        sum = 0u; cnt = 0u; mine = 0u;
#pragma unroll
        for (unsigned j = 0; j < 16; ++j) { const unsigned c = xb_ld(&bar[XB_XCNT(j)]); sum += c; cnt += (c > 0u) ? 1u : 0u; mine = (j == x) ? c : mine; }
        if (sum == G) break;
        __builtin_amdgcn_s_sleep(1);
        if ((++sp & 255u) == 0u) { if (xb_ld(&bar[XB_TMO])) break; if (sp > XB_SPIN_CAP) { atomicAdd(&bar[XB_TMO], 1u); break; } }
    }
    nloc = mine > 0u ? mine : 1u; nx = cnt > 0u ? cnt : 1u;
}
DI void xcd_barrier(const XcdBarrier& b) {
    asm volatile("s_waitcnt vmcnt(0)" ::: "memory");
    __syncthreads();
    if (threadIdx.x == 0) {
        unsigned* bar = b.bar;
        __builtin_amdgcn_s_waitcnt(0);
        unsigned nloc = b.st[0], nx = b.st[1];
        if (nloc == 0u) { xcd_barrier_complete(bar, b.x, nloc, nx); b.st[0] = nloc; b.st[1] = nx; }
        const unsigned old = xb_add(&bar[XB_XSUB(b.x)], 1u);
        const unsigned gen = old / nloc;
        if (old + 1u == (gen + 1u) * nloc) {
            __builtin_amdgcn_fence(__ATOMIC_RELEASE, "agent");
            asm volatile("s_waitcnt vmcnt(0)" ::: "memory");
            const unsigned og = xb_add(&bar[XB_TOP], 1u);
            const unsigned tg = og / nx;
            if (og + 1u == (tg + 1u) * nx) xb_add(&bar[XB_TOPGEN], 1u);
            else XB_SPIN(xb_ld(&bar[XB_TOPGEN]) == tg, bar);
            __builtin_amdgcn_fence(__ATOMIC_ACQUIRE, "agent");
            xb_add(&bar[XB_XGEN(b.x)], 1u);
            asm volatile("s_waitcnt vmcnt(0)" ::: "memory");
        } else {
            XB_SPIN(xb_ld(&bar[XB_XGEN(b.x)]) == gen, bar);
            __builtin_amdgcn_fence(__ATOMIC_ACQUIRE, "agent");
            asm volatile("s_waitcnt vmcnt(0)" ::: "memory");
        }
    }
    __syncthreads();
}

DI void run_phase(const Ctx& F, int ph) {
    if (ph == 0) { if (PHON(8)) phase_convert(F, 0, F.blk, F.G, 1 | 16); if (PHON(9)) phase_norm<0>(F, 0, true); return; }
    const int q = ph - 1, l = q / 11, s_ = q - 11 * l;
    const int s = s_ == 0 ? 0 : s_ == 1 ? 8 : s_ == 2 ? 1 : s_ == 3 ? 9 : s_ == 4 ? 2 : s_ == 5 ? 10 : s_ - 3;
    switch (s) {
    case 0: if (PHON(0)) { pg8::Gemm g{F.hb(), F.wt_in(l), D}; pg8::StaticOrder S; S.init(MROWS, NZ, D, F.G, F.blk);
        pg8::EpiBf16<0> E{F.zb(), NZ, 0}; pg8::gemm_phase(F.lds, F.tid, g, S, E); } break;
    case 1: if (PHON(1)) phase_mixer(F, l); break;
    case 2: if (PHON(2)) { pg8::Gemm g{F.ocat(), F.wt_br(l), 3072}; pg8::SegOrder S; S.init(MROWS, D, F.G, F.blk);
        pg8::EpiBf16<0> E{F.pbr(), 3 * D, D}; pg8::gemm_phase(F.lds, F.tid, g, S, E);
        if (l == 0 && F.blk >= 48) phase_convert(F, 1, F.blk - 48, F.G - 48, 1); } break;
    case 3: case 6: if (PHON(3)) {
        const bool dn = (s == 6);
        pg8::Gemm g{dn ? F.zb() : F.mb(), dn ? F.wt_dn(l) : F.wt_o(l), dn ? DFF : D};
        pg8::TailOrder S; S.init(dn ? DFF : D, F.blk, dn ? 3 : 2);
        pg8::EpiRes E{(!dn && l == 0) ? F.in0 : F.xws(), F.xws(), F.part()};
        pg8::gemm_phase(F.lds, F.tid, g, S, E); } break;
    case 4: if (PHON(4)) phase_norm<1>(F, l, false); break;
    case 5: if (PHON(5)) { pg8::Gemm g{F.hb(), F.wt_up(l), D}; pg8::StaticOrder S; S.init(MROWS, DFF, D, F.G, F.blk);
        pg8::EpiBf16<1> E{F.zb(), DFF, 0}; pg8::gemm_phase(F.lds, F.tid, g, S, E);
        if (l == 0 && F.blk >= 64) phase_convert(F, 1, F.blk - 64, F.G - 64, 16 | 2); } break;
    case 8: phase_prep(F, l); break;
    case 9: phase_post(F, l); break;
    case 10: phase_merge(F); break;
    default: if (PHON(7)) { if (l == 0) phase_norm<0>(F, 1, false); else phase_norm<2>(F, 0, false); } break;
    }
}
constexpr int N_PHASES = 23;

__global__ void __launch_bounds__(512, 2) fwd_kernel(Args a) {
    extern __shared__ __attribute__((aligned(16))) unsigned char lds_raw[];
    typedef const __attribute__((address_space(4))) Args* ArgsP;
    volatile LAS unsigned* xb_st = (volatile LAS unsigned*)((LAS unsigned char*)lds_raw + LDS_XB);
    if (a.ph_hi - a.ph_lo > 1) {
        if (threadIdx.x == 0) { xb_st[0] = 0u; xb_st[1] = 0u; }
        __syncthreads();
        if (threadIdx.x == 0) (void)xb_add(&((unsigned*)(a.ws + WS_BAR))[XB_XCNT(xb_xcc_id())], 1u);
    }
    for (int ph = a.ph_lo; ph < a.ph_hi; ++ph) {
        Ctx F;
        {
            ArgsP ap = (ArgsP)__builtin_amdgcn_kernarg_segment_ptr(); asm volatile("" : "+s"(ap));
            F.in0 = ap->in[0]; F.in1 = ap->in[1]; F.in2 = ap->in[2]; F.in3 = ap->in[3]; F.in4 = ap->in[4]; F.in5 = ap->in[5]; F.in6 = ap->in[6]; F.in7 = ap->in[7]; F.in8 = ap->in[8]; F.in9 = ap->in[9]; F.in10 = ap->in[10];
            F.in11 = ap->in[11]; F.in12 = ap->in[12]; F.in13 = ap->in[13]; F.in14 = ap->in[14]; F.in15 = ap->in[15]; F.in16 = ap->in[16]; F.in17 = ap->in[17]; F.in18 = ap->in[18]; F.in19 = ap->in[19]; F.in20 = ap->in[20];
            F.out = ap->out; F.ws = ap->ws; F.lds = (LAS unsigned char*)lds_raw; F.G = gridDim.x; F.blk = blockIdx.x;
            int t_ = threadIdx.x; asm volatile("" : "+v"(t_)); F.tid = t_; F.lane = t_ & 63; F.wave = __builtin_amdgcn_readfirstlane(t_ >> 6);
        }
        run_phase(F, ph);
#ifdef PROBE_DUP
        if ((PROBE_DUP >> (ph == 0 ? 15 : ((ph - 1) % 11))) & 1) { __syncthreads(); cg::this_grid().sync(); run_phase(F, ph); }
#endif
        if (ph + 1 < a.ph_hi) {
            if (a.ph_lo < 0) cg::this_grid().sync();
            { XcdBarrier xb; xb.bar = (unsigned*)(a.ws + WS_BAR); xb.x = xb_xcc_id(); xb.st = xb_st; xcd_barrier(xb); }
        }
    }
}

extern "C" void kernel_launch(void* const* d_in, const int* in_sizes, int n_in, void* d_out, int out_size, void* d_ws, size_t ws_size, hipStream_t stream) {
    static int grid = 0;
    if (grid == 0) {
        if (n_in != 21 || ws_size < WS_END) { fprintf(stderr, "kernel_launch: need 21 inputs and >= %zu bytes of workspace (got %d, %zu)\n", (size_t)WS_END, n_in, ws_size); grid = -1; return; }
        int dev = 0, cus = 0, per_cu = 0;
        hipGetDevice(&dev);
        hipDeviceGetAttribute(&cus, hipDeviceAttributeMultiprocessorCount, dev);
        if (hipFuncSetAttribute((const void*)fwd_kernel, hipFuncAttributeMaxDynamicSharedMemorySize, LDS_BYTES) != hipSuccess) { fprintf(stderr, "kernel_launch: hipFuncSetAttribute failed\n"); grid = -1; return; }
        if (hipOccupancyMaxActiveBlocksPerMultiprocessor(&per_cu, (const void*)fwd_kernel, 512, LDS_BYTES) != hipSuccess || per_cu < 1) { fprintf(stderr, "kernel_launch: occupancy query says %d blocks per CU\n", per_cu); per_cu = 1; }
        (void)hipGetLastError();
        if (cus != 256) { fprintf(stderr, "kernel_launch: built for a 256-CU device (got %d CUs)\n", cus); grid = -1; return; }
        grid = cus;
    }
    if (grid < 0) return;
    Args a{};
    for (int i = 0; i < 21; ++i) a.in[i] = (const float*)d_in[i];
    a.out = (float*)d_out; a.ws = (unsigned char*)d_ws;
#if MK_MULTI
    for (int ph = 0; ph < N_PHASES; ++ph) { a.ph_lo = ph; a.ph_hi = ph + 1;
        hipLaunchKernelGGL(fwd_kernel, dim3(grid), dim3(512), LDS_BYTES, stream, a); }
#else
    a.ph_lo = 0; a.ph_hi = N_PHASES;
    if (hipMemsetAsync((unsigned char*)d_ws + WS_BAR, 0, 16384, stream) != hipSuccess) { fprintf(stderr, "kernel_launch: hipMemsetAsync of the barrier words failed\n"); return; }
    void* args[] = {&a};
    hipError_t e = hipLaunchCooperativeKernel((const void*)fwd_kernel, dim3(grid), dim3(512), args, LDS_BYTES, stream);
    if (e != hipSuccess) fprintf(stderr, "kernel_launch: cooperative launch failed: %s (grid %d)\n", hipGetErrorString(e), grid);
#endif
}
```
